# Optimizing an MI355X kernel written in HIP

```python
import math
import jax, jax.numpy as jnp
from jax import lax
import numpy as np

D_MODEL = 2048
BATCH = 1
SEQ = 8192
DEPTH = 4

CHUNK = 64
D_MIX = 2 * D_MODEL
SSD_WIDTH = D_MIX // 2
SBA_WIDTH = D_MIX - SSD_WIDTH
SSD_HEAD_DIM = 64
SSD_HEADS = SSD_WIDTH // SSD_HEAD_DIM
SSD_GROUPS = 4
SSD_STATE = 128
SSD_CONV = 4
SBA_HEAD_DIM = 128
SBA_HEADS = SBA_WIDTH // SBA_HEAD_DIM
Q_BLOCK = 128
EPS = 1e-6
CONV_DIM = SSD_WIDTH + 2 * SSD_GROUPS * SSD_STATE
IN_SPLITS = (
    SSD_WIDTH,
    SSD_WIDTH + CONV_DIM,
    SSD_WIDTH + CONV_DIM + SSD_HEADS,
    SSD_WIDTH + CONV_DIM + SSD_HEADS + SBA_WIDTH,
    SSD_WIDTH + CONV_DIM + SSD_HEADS + 2 * SBA_WIDTH,
    SSD_WIDTH + CONV_DIM + SSD_HEADS + 3 * SBA_WIDTH,
)
IN_COLS = SSD_WIDTH + CONV_DIM + SSD_HEADS + 4 * SBA_WIDTH

kernel_name = "hybrid_ssd_stickbreaking_parallel_heads"


def rmsnorm(x, w):
    xf = x.astype(jnp.float32)
    y = xf * lax.rsqrt(jnp.mean(xf * xf, axis=-1, keepdims=True) + EPS)
    return (y * w.astype(jnp.float32)).astype(x.dtype)


def causal_depthwise_conv(u, w, b):
    k_taps = w.shape[0]
    seq = u.shape[1]
    up = jnp.pad(u, ((0, 0), (k_taps - 1, 0), (0, 0)))
    out = b
    for j in range(k_taps):
        out = out + w[j] * up[:, j:j + seq]
    return out


def ssd_chunked_scan(x, dt, a_head, bm, cm):
    bsz, seq, n_heads, hd = x.shape
    g, n = bm.shape[2], bm.shape[3]
    r = n_heads // g
    nc = seq // CHUNK
    xs = (x.astype(jnp.float32) * dt[..., None]).reshape(bsz, nc, CHUNK, g, r, hd)
    da = (dt * a_head).reshape(bsz, nc, CHUNK, g, r).transpose(0, 3, 4, 1, 2)
    bc = bm.astype(jnp.float32).reshape(bsz, nc, CHUNK, g, n)
    cc = cm.astype(jnp.float32).reshape(bsz, nc, CHUNK, g, n)
    a_cum = jnp.cumsum(da, axis=-1)
    tri = jnp.tril(jnp.ones((CHUNK, CHUNK), dtype=bool))
    seg = a_cum[..., :, None] - a_cum[..., None, :]
    decay_in = jnp.exp(jnp.where(tri, seg, -jnp.inf))
    cb = jnp.einsum('bclgn,bcsgn->bgcls', cc, bc)
    y_diag = jnp.einsum('bgcls,bgrcls,bcsgrp->bclgrp', cb, decay_in, xs)
    decay_states = jnp.exp(a_cum[..., -1:] - a_cum)
    states = jnp.einsum('bclgn,bgrcl,bclgrp->cbgrpn', bc, decay_states, xs)
    chunk_decay = jnp.exp(a_cum[..., -1]).transpose(3, 0, 1, 2)

    def step(h, inp):
        s_c, d_c = inp
        return h * d_c[..., None, None] + s_c, h

    _, prev = lax.scan(step, jnp.zeros(states.shape[1:], jnp.float32), (states, chunk_decay))
    y_off = jnp.einsum('bclgn,cbgrpn,bgrcl->bclgrp', cc, prev, jnp.exp(a_cum))
    return (y_diag + y_off).reshape(bsz, seq, n_heads * hd)


def stick_breaking_attention(q, k, v):
    bsz, n_heads, seq, hd = q.shape
    n_blocks = seq // Q_BLOCK
    scale = 1.0 / math.sqrt(hd)
    kf = k.astype(jnp.float32)
    vf = v.astype(jnp.float32)
    key_pos = jnp.arange(seq)

    def block(i):
        start = i * Q_BLOCK
        qb = lax.dynamic_slice_in_dim(q, start, Q_BLOCK, axis=2).astype(jnp.float32)
        z = jnp.einsum('bhqd,bhkd->bhqk', qb, kf) * scale
        qpos = start + jnp.arange(Q_BLOCK)
        earlier = key_pos[None, :] < qpos[:, None]
        log_keep = jnp.where(earlier, jax.nn.log_sigmoid(-z), 0.0)
        later_sum = lax.cumsum(log_keep, axis=3, reverse=True) - log_keep
        weight = jnp.where(earlier, jnp.exp(jax.nn.log_sigmoid(z) + later_sum), 0.0)
        return jnp.einsum('bhqk,bhkd->bhqd', weight, vf)

    out = lax.map(block, jnp.arange(n_blocks))
    return out.transpose(1, 0, 3, 2, 4).reshape(bsz, seq, n_heads * hd)


def hybrid_layer(x, norm_w, w_in, conv_w, conv_b, dt_bias, a_log, d_skip, ssd_norm_w, w_out):
    bsz, seq, _ = x.shape
    h = rmsnorm(x, norm_w)
    proj = h @ w_in
    z, xbc, dt_raw, q, k, v, g = jnp.split(proj, IN_SPLITS, axis=-1)

    xbc = jax.nn.silu(causal_depthwise_conv(xbc, conv_w, conv_b))
    gn = SSD_GROUPS * SSD_STATE
    xs, bm, cm = jnp.split(xbc, (SSD_WIDTH, SSD_WIDTH + gn), axis=-1)
    xs = xs.reshape(bsz, seq, SSD_HEADS, SSD_HEAD_DIM)
    bm = bm.reshape(bsz, seq, SSD_GROUPS, SSD_STATE)
    cm = cm.reshape(bsz, seq, SSD_GROUPS, SSD_STATE)
    dt = jax.nn.softplus(dt_raw.astype(jnp.float32) + dt_bias.astype(jnp.float32))
    a_head = -jnp.exp(a_log.astype(jnp.float32))
    y = ssd_chunked_scan(xs, dt, a_head, bm, cm)
    y = y + (d_skip.astype(jnp.float32)[:, None] * xs.astype(jnp.float32)).reshape(bsz, seq, SSD_WIDTH)
    yg = (y * jax.nn.silu(z.astype(jnp.float32))).reshape(bsz, seq, SSD_GROUPS, SSD_WIDTH // SSD_GROUPS)
    yg = yg * lax.rsqrt(jnp.mean(yg * yg, axis=-1, keepdims=True) + EPS)
    y_ssd = yg.reshape(bsz, seq, SSD_WIDTH) * ssd_norm_w.astype(jnp.float32)

    def heads(t):
        return t.reshape(bsz, seq, SBA_HEADS, SBA_HEAD_DIM).transpose(0, 2, 1, 3)
    o = stick_breaking_attention(heads(q), heads(k), heads(v))
    y_sba = o * jax.nn.silu(g.astype(jnp.float32))

    mix = jnp.concatenate([y_ssd, y_sba], axis=-1).astype(x.dtype)
    return x + mix @ w_out


def setup_inputs(seed: int = 0) -> dict:
    key = jax.random.key(seed)
    ks = jax.random.split(key, 12)
    f32 = jnp.float32
    x = jax.random.normal(ks[0], (BATCH, SEQ, D_MODEL), f32)
    norm_w = 1.0 + 0.02 * jax.random.normal(ks[1], (DEPTH, D_MODEL), f32)
    w_in = jax.random.normal(ks[2], (DEPTH, D_MODEL, IN_COLS), f32) * D_MODEL ** -0.5
    conv_w = jax.random.normal(ks[3], (DEPTH, SSD_CONV, CONV_DIM), f32) * SSD_CONV ** -0.5
    conv_b = 0.02 * jax.random.normal(ks[4], (DEPTH, CONV_DIM), f32)
    dt0 = jnp.exp(jax.random.uniform(ks[5], (DEPTH, SSD_HEADS), f32,
                                     math.log(1e-3), math.log(1e-1)))
    dt_bias = dt0 + jnp.log(-jnp.expm1(-dt0))
    a_log = jnp.log(jax.random.uniform(ks[6], (DEPTH, SSD_HEADS), f32, 1.0, 16.0))
    d_skip = 1.0 + 0.02 * jax.random.normal(ks[7], (DEPTH, SSD_HEADS), f32)
    ssd_norm_w = 1.0 + 0.02 * jax.random.normal(ks[8], (DEPTH, SSD_WIDTH), f32)
    w_out = jax.random.normal(ks[9], (DEPTH, D_MIX, D_MODEL), f32) * D_MIX ** -0.5
    final_norm_w = 1.0 + 0.02 * jax.random.normal(ks[10], (D_MODEL,), f32)
    return {"x": x, "norm_w": norm_w, "w_in": w_in, "conv_w": conv_w, "conv_b": conv_b,
            "dt_bias": dt_bias, "a_log": a_log, "d_skip": d_skip, "ssd_norm_w": ssd_norm_w,
            "w_out": w_out, "final_norm_w": final_norm_w}


def reference(x, norm_w, w_in, conv_w, conv_b, dt_bias, a_log, d_skip, ssd_norm_w, w_out, final_norm_w):
    h = x
    for i in range(DEPTH):
        h = hybrid_layer(h, norm_w[i], w_in[i], conv_w[i], conv_b[i], dt_bias[i], a_log[i],
                         d_skip[i], ssd_norm_w[i], w_out[i])
    return rmsnorm(h, final_norm_w)
```

```cpp
#include <hip/hip_runtime.h>
#include <hip/hip_cooperative_groups.h>
#include <cstdio>
#include <cstdint>
namespace cg = cooperative_groups;

#ifndef DUPM
#define DUPM 0
#endif
#ifndef SKIPM
#define SKIPM 0
#endif
#ifndef ONE_LAUNCH
#define ONE_LAUNCH 1
#endif

#define LAS __attribute__((address_space(3)))
#define DI __device__ __forceinline__
typedef unsigned short bf16_t;
typedef short bf16x8 __attribute__((ext_vector_type(8)));
typedef float f32x4 __attribute__((ext_vector_type(4)));
typedef unsigned u32x4 __attribute__((ext_vector_type(4)));
typedef unsigned u32x2 __attribute__((ext_vector_type(2)));

constexpr int S = 8192, DM = 2048, NL = 4, NPROJ = 13312, INCOLS = 13344, DMIX = 4096;
constexpr int ZOFF = 0, XOFF = 2048, BOFF = 4096, COFF = 4608, QOFF = 5120, KOFF = 7168, VOFF = 9216, GOFF = 11264;
constexpr int NCHUNK = 128, NH = 32, CONVD = 3072;
constexpr float EPS = 1e-6f;
constexpr int LDS_BYTES = 147456;
constexpr int NPHASE = 2 + 5 * NL;

constexpr size_t WS_WIN = 0;
constexpr size_t WS_WDT = WS_WIN + (size_t)NL * NPROJ * DM * 2;
constexpr size_t WS_WOUT = WS_WDT + (size_t)NL * 32 * DM * 2;
constexpr size_t WS_XB = WS_WOUT + (size_t)NL * DM * DMIX * 2;
constexpr size_t WS_XRES = WS_XB + (size_t)S * DM * 2;
constexpr size_t WS_PROJ = WS_XRES + (size_t)S * DM * 4;
constexpr size_t WS_DTRAW = WS_PROJ + (size_t)S * NPROJ * 2;
constexpr size_t WS_MIX = WS_DTRAW + (size_t)S * 32 * 4;
constexpr size_t WS_STATES = WS_MIX + (size_t)S * DMIX * 2;
constexpr size_t WS_CDEC = WS_STATES + (size_t)NCHUNK * NH * 64 * 128 * 2;
constexpr size_t WS_SSP = WS_CDEC + (size_t)NCHUNK * NH * 4;
constexpr size_t WS_XACT = WS_SSP + (size_t)8 * S * 4;
constexpr size_t WS_BAR = WS_XACT + (size_t)S * CONVD * 2;
constexpr size_t WS_END = WS_BAR + 16384;

DI unsigned pk2(float lo, float hi) { unsigned r; asm volatile("v_cvt_pk_bf16_f32 %0, %1, %2" : "=v"(r) : "v"(lo), "v"(hi)); return r; }
DI int opaque_tid() { int t = threadIdx.x; asm volatile("" : "+v"(t)); return t; }
DI float bf_lo(unsigned w) { return __uint_as_float(w << 16); }
DI float bf_hi(unsigned w) { return __uint_as_float(w & 0xffff0000u); }
DI float silu_f(float x) { return x * __builtin_amdgcn_rcpf(1.0f + __expf(-x)); }
DI f32x4 mfma16(bf16x8 a, bf16x8 b, f32x4 c) { return __builtin_amdgcn_mfma_f32_16x16x32_bf16(a, b, c, 0, 0, 0); }
typedef short s16x4 __attribute__((ext_vector_type(4)));
DI bf16x8 tr_frag(LAS unsigned char* base, int stride_el, int row0, int col0, int fr) {
    const int q = fr >> 2, p_ = fr & 3;
    LAS unsigned char* p0 = base + ((row0 + q) * stride_el + col0 + 4 * p_) * 2;
    const s16x4 lo = __builtin_amdgcn_ds_read_tr16_b64_v4i16((LAS s16x4*)p0);
    const s16x4 hi = __builtin_amdgcn_ds_read_tr16_b64_v4i16((LAS s16x4*)(p0 + 8 * stride_el));
    bf16x8 r; r[0] = lo[0]; r[1] = lo[1]; r[2] = lo[2]; r[3] = lo[3]; r[4] = hi[0]; r[5] = hi[1]; r[6] = hi[2]; r[7] = hi[3];
    return r;
}
DI float row_rstd(const float* ssp, int row) {
    float s = 0.f;
#pragma unroll
    for (int j = 0; j < 8; ++j) s += ssp[j * S + row];
    return rsqrtf(s * (1.0f / DM) + EPS);
}

namespace pg8 {
constexpr int BM = 256, BK = 64, HALF = 128, HTB = HALF * BK * 2, STAGE_BYTES = 8 * HTB, NXCD = 8, WGM = 8;
DI int lds_byte(int r, int c) { const int st = (r >> 4) * 2 + (c >> 5), rr = r & 15, cc = c & 31, ob = rr * 64 + cc * 2; return st * 1024 + (ob ^ (((ob >> 9) & 1) << 5)); }
DI void stage_rc(int b, int& R, int& C) { const int st = b / 1024, sb = b % 1024, swz = sb ^ (((sb >> 9) & 1) << 5); R = (st >> 1) * 16 + swz / 64; C = (st & 1) * 32 + (swz % 64) / 2; }
DI int perm32(int rho) { const int n = rho >> 4, i = rho & 15; return 8 * (i >> 2) + 4 * n + (i & 3); }
struct Unit { int pm, pn; };
struct Gemm { const bf16_t* A; const bf16_t* Bt; int M, N, K; };
struct StaticOrder {
    int nM, nN, nwg, G, c;
    DI void init(int M, int N, int G_, int c_) { nM = M / BM; nN = N / BM; nwg = nM * nN; G = G_; c = c_; }
    DI bool next(int i, Unit& u) const {
        const long L = (long)i * G + c; if (L >= nwg) return false;
        int wgid = (int)L; { const int q = nwg / NXCD, r = nwg % NXCD, xcd = wgid % NXCD, off = wgid / NXCD; wgid = (xcd < r ? xcd * (q + 1) : r * (q + 1) + (xcd - r) * q) + off; }
        const int nig = WGM * nN, gid = wgid / nig, fm = gid * WGM, gsz = (nM - fm) < WGM ? (nM - fm) : WGM;
        u.pm = fm + ((wgid % nig) % gsz); u.pn = (wgid % nig) / gsz; return true;
    }
};

template <class Epi>
DI void gemm_phase(LAS unsigned char* lds, const Gemm g, const StaticOrder& S_, const Epi& E) {
    const int tid = opaque_tid(), wid = __builtin_amdgcn_readfirstlane(tid >> 6), lane = tid & 63, wr = wid >> 2, wc = wid & 3, fr = lane & 15, fq = lane >> 4;
    const int K = g.K, nt = K / BK;
    unsigned voffA[2], voffB[2];
#pragma unroll
    for (int i = 0; i < 2; ++i) { int R, C; stage_rc(tid * 16 + i * 8192, R, C); const int Rb = Epi::PERM ? ((R >> 5) * 64 + perm32(R & 31)) : R;
        voffA[i] = (unsigned)(R * K + C) * 2u; voffB[i] = (unsigned)(Rb * K + C) * 2u; }
    const size_t kstep = (size_t)(BK * 2);
    const size_t hstep = (size_t)HALF * K * 2;
    const size_t tstep = 2 * hstep;
    const size_t hstepB = Epi::PERM ? (size_t)32 * K * 2 : hstep;
    const unsigned ldsw = (unsigned)wid * 1024u;
    const int aoff = lds_byte(wr * 64 + fr, fq * 8), boff = lds_byte(wc * 32 + fr, fq * 8);
#define PG8_SA(b, h) (((b) * 2 + (h)) * HTB)
#define PG8_SB(b, h) ((4 + (b) * 2 + (h)) * HTB)
#define PG8_STAGE(bufoff, gbase, voff) do { _Pragma("unroll") for (int _i = 0; _i < 2; ++_i) \
        __builtin_amdgcn_global_load_lds((const unsigned*)((const char*)(gbase) + (voff)[_i]), (LAS unsigned*)(lds + (bufoff) + ldsw + _i * 8192), 16, 0, 0); } while (0)
#define PG8_LDA(dst, b, h) do { _Pragma("unroll") for (int m = 0; m < 4; ++m) _Pragma("unroll") for (int k = 0; k < 2; ++k) dst[m][k] = *(const LAS bf16x8*)(lds + PG8_SA(b, h) + aoff + m * 2048 + k * 1024); } while (0)
#define PG8_LDB(dst, b, h) do { _Pragma("unroll") for (int n = 0; n < 2; ++n) _Pragma("unroll") for (int k = 0; k < 2; ++k) dst[n][k] = *(const LAS bf16x8*)(lds + PG8_SB(b, h) + boff + n * 2048 + k * 1024); } while (0)
#define PG8_MMA(ai, bj, At, Bt) do { __builtin_amdgcn_s_setprio(1); _Pragma("unroll") for (int m = 0; m < 4; ++m) _Pragma("unroll") for (int n = 0; n < 2; ++n) _Pragma("unroll") for (int k = 0; k < 2; ++k) \
        acc[ai][bj][m][n] = __builtin_amdgcn_mfma_f32_16x16x32_bf16(Bt[n][k], At[m][k], acc[ai][bj][m][n], 0, 0, 0); __builtin_amdgcn_s_setprio(0); } while (0)
#define PG8_WAIT_V(n) asm volatile("s_waitcnt vmcnt(" #n ")" ::: "memory")
#define PG8_WAIT_L(n) asm volatile("s_waitcnt lgkmcnt(" #n ")" ::: "memory")
#define PG8_BAR __builtin_amdgcn_s_barrier()
#define PG8_SCHED __builtin_amdgcn_sched_barrier(0)
    Unit cur, nxt; int ui = 0;
    if (!S_.next(0, cur)) return;
    f32x4 acc[2][2][4][2];
#pragma unroll
    for (int a = 0; a < 2; ++a)
#pragma unroll
        for (int b = 0; b < 2; ++b)
#pragma unroll
            for (int m = 0; m < 4; ++m)
#pragma unroll
                for (int n = 0; n < 2; ++n) acc[a][b][m][n] = (f32x4){0.f, 0.f, 0.f, 0.f};
    bf16x8 At[4][2], B0[2][2], B1[2][2];
    const char* cA = (const char*)g.A + (size_t)cur.pm * tstep; const char* cB = (const char*)g.Bt + (size_t)cur.pn * tstep;
    PG8_STAGE(PG8_SB(0, 0), cB, voffB); PG8_STAGE(PG8_SA(0, 0), cA, voffA); PG8_STAGE(PG8_SB(0, 1), cB + hstepB, voffB); PG8_STAGE(PG8_SA(0, 1), cA + hstep, voffA);
    if (wr == 1) PG8_BAR;
    PG8_WAIT_V(4); PG8_BAR;
    PG8_STAGE(PG8_SB(1, 0), cB + kstep, voffB); PG8_STAGE(PG8_SA(1, 0), cA + kstep, voffA); PG8_STAGE(PG8_SB(1, 1), cB + hstepB + kstep, voffB);
    PG8_WAIT_V(6); PG8_BAR;
    for (;;) {
        const bool has_next = S_.next(ui + 1, nxt);
        const char* nA = has_next ? (const char*)g.A + (size_t)nxt.pm * tstep : cA; const char* nB = has_next ? (const char*)g.Bt + (size_t)nxt.pn * tstep : cB;
        for (int t = 0; t < nt; t += 2) {
            const bool last = (t == nt - 2);
            const char* a1 = cA + (size_t)(t + 1) * kstep;
            const char* a2 = last ? nA : cA + (size_t)(t + 2) * kstep; const char* b2 = last ? nB : cB + (size_t)(t + 2) * kstep;
            const char* a3 = a2 + kstep; const char* b3 = b2 + kstep;
            PG8_LDB(B0, 0, 0); PG8_SCHED; PG8_LDA(At, 0, 0); PG8_STAGE(PG8_SA(1, 1), a1 + hstep, voffA);
            PG8_WAIT_L(8); PG8_BAR; PG8_WAIT_L(0); PG8_MMA(0, 0, At, B0); PG8_BAR; PG8_SCHED;
            PG8_LDB(B1, 0, 1); PG8_STAGE(PG8_SB(0, 0), b2, voffB);
            PG8_BAR; PG8_WAIT_L(0); PG8_MMA(0, 1, At, B1); PG8_BAR;
            PG8_LDA(At, 0, 1); PG8_STAGE(PG8_SA(0, 0), a2, voffA);
            PG8_BAR; PG8_WAIT_L(0); PG8_MMA(1, 0, At, B0); PG8_BAR; PG8_SCHED;
            PG8_STAGE(PG8_SB(0, 1), b2 + hstepB, voffB);
            PG8_WAIT_V(6); PG8_BAR; PG8_MMA(1, 1, At, B1); PG8_BAR;
            PG8_LDB(B0, 1, 0); PG8_SCHED; PG8_LDA(At, 1, 0); PG8_STAGE(PG8_SA(0, 1), a2 + hstep, voffA);
            PG8_WAIT_L(8); PG8_BAR; PG8_WAIT_L(0); PG8_MMA(0, 0, At, B0); PG8_BAR; PG8_SCHED;
            PG8_LDB(B1, 1, 1); PG8_STAGE(PG8_SB(1, 0), b3, voffB);
            PG8_BAR; PG8_WAIT_L(0); PG8_MMA(0, 1, At, B1); PG8_BAR;
            PG8_LDA(At, 1, 1); PG8_STAGE(PG8_SA(1, 0), a3, voffA);
            PG8_BAR; PG8_WAIT_L(0); PG8_MMA(1, 0, At, B0); PG8_BAR; PG8_SCHED;
            PG8_STAGE(PG8_SB(1, 1), b3 + hstepB, voffB);
            PG8_WAIT_V(6); PG8_BAR; PG8_MMA(1, 1, At, B1); PG8_BAR;
        }
        if constexpr (!Epi::AFTER_DRAIN) { E(acc, cur, wr, wc, fr, fq); }
        if (!has_next) break;
#pragma unroll
        for (int a = 0; a < 2; ++a)
#pragma unroll
            for (int b = 0; b < 2; ++b)
#pragma unroll
                for (int m = 0; m < 4; ++m)
#pragma unroll
                    for (int n = 0; n < 2; ++n) acc[a][b][m][n] = (f32x4){0.f, 0.f, 0.f, 0.f};
        cur = nxt; cA = nA; cB = nB; ++ui;
    }
    PG8_WAIT_V(0);
    if (wr == 0) PG8_BAR;
    PG8_BAR;
    if constexpr (Epi::AFTER_DRAIN) { E.fused(acc, cur, wr, wc, fr, fq, lds, wid, lane); }
#undef PG8_SA
#undef PG8_SB
#undef PG8_STAGE
#undef PG8_LDA
#undef PG8_LDB
#undef PG8_MMA
#undef PG8_WAIT_V
#undef PG8_WAIT_L
#undef PG8_BAR
#undef PG8_SCHED
}

struct EpiInProj {
    static constexpr bool PERM = true, AFTER_DRAIN = false;
    bf16_t* O; const float* ssp; const LAS float* rs_lds; int pm0;
    DI void operator()(const f32x4 (&acc)[2][2][4][2], const Unit& u, int wr, int wc, int fr, int fq) const {
        const int row0 = u.pm * BM + wr * 64 + fr; const int col0 = u.pn * BM + wc * 64 + 8 * fq;
        const bool lds_ok = (u.pm == pm0);
#pragma unroll
        for (int ai = 0; ai < 2; ++ai)
#pragma unroll
            for (int m = 0; m < 4; ++m) {
                const int row = row0 + ai * HALF + m * 16;
                const float rs = lds_ok ? rs_lds[wr * 64 + fr + ai * HALF + m * 16] : row_rstd(ssp, row);
                bf16_t* rowp = O + (size_t)row * NPROJ + col0;
#pragma unroll
                for (int bj = 0; bj < 2; ++bj) {
                    const f32x4 v0 = acc[ai][bj][m][0] * rs, v1 = acc[ai][bj][m][1] * rs;
                    u32x4 w; w.x = pk2(v0[0], v0[1]); w.y = pk2(v0[2], v0[3]); w.z = pk2(v1[0], v1[1]); w.w = pk2(v1[2], v1[3]);
                    *(u32x4*)(rowp + bj * 32) = w;
                }
            }
    }
};
struct EpiOutProj {
    static constexpr bool PERM = true, AFTER_DRAIN = true;
    bf16_t* xb; float* ssp;
    DI void operator()(const f32x4 (&)[2][2][4][2], const Unit&, int, int, int, int) const {}
    DI void fused(const f32x4 (&acc)[2][2][4][2], const Unit& u, int wr, int wc, int fr, int fq, LAS unsigned char* lds, int wid, int lane) const {
        LAS float* red = (LAS float*)lds;
        const int row0 = u.pm * BM + wr * 64 + fr; const int col0 = u.pn * BM + wc * 64 + 8 * fq;
        u32x4 xo[2][4][2];
#pragma unroll
        for (int ai = 0; ai < 2; ++ai)
#pragma unroll
            for (int m = 0; m < 4; ++m)
#pragma unroll
                for (int bj = 0; bj < 2; ++bj) xo[ai][m][bj] = *(const u32x4*)(xb + (size_t)(row0 + ai * HALF + m * 16) * DM + col0 + bj * 32);
#pragma unroll
        for (int ai = 0; ai < 2; ++ai)
#pragma unroll
            for (int m = 0; m < 4; ++m) {
                const int row = row0 + ai * HALF + m * 16; float ss = 0.f;
#pragma unroll
                for (int bj = 0; bj < 2; ++bj) {
                    const u32x4 o = xo[ai][m][bj];
                    const f32x4 a0 = acc[ai][bj][m][0], a1 = acc[ai][bj][m][1];
                    u32x4 pb;
                    pb.x = pk2(bf_lo(o.x) + a0[0], bf_hi(o.x) + a0[1]); pb.y = pk2(bf_lo(o.y) + a0[2], bf_hi(o.y) + a0[3]);
                    pb.z = pk2(bf_lo(o.z) + a1[0], bf_hi(o.z) + a1[1]); pb.w = pk2(bf_lo(o.w) + a1[2], bf_hi(o.w) + a1[3]);
                    *(u32x4*)(xb + (size_t)row * DM + col0 + bj * 32) = pb;
                    const float y0 = bf_lo(pb.x), y1 = bf_hi(pb.x), y2 = bf_lo(pb.y), y3 = bf_hi(pb.y), y4 = bf_lo(pb.z), y5 = bf_hi(pb.z), y6 = bf_lo(pb.w), y7 = bf_hi(pb.w);
                    ss += ((y0 * y0 + y1 * y1) + (y2 * y2 + y3 * y3)) + ((y4 * y4 + y5 * y5) + (y6 * y6 + y7 * y7));
                }
                ss += __shfl_xor(ss, 16); ss += __shfl_xor(ss, 32);
                if (fq == 0) red[wc * 256 + wr * 64 + fr + ai * HALF + m * 16] = ss;
            }
        __syncthreads();
        const int tid = opaque_tid();
        if (tid < 256) ssp[(size_t)u.pn * S + u.pm * BM + tid] = (red[tid] + red[256 + tid]) + (red[512 + tid] + red[768 + tid]);
        __syncthreads();
    }
};
}

#define XB_TMO      128
#define XB_XCNT(j)  (256  + 64 * (j))
#define XB_XSUB(j)  (1280 + 64 * (j))
#define XB_XGEN(j)  (2304 + 64 * (j))
#define XB_TOP      3328
#define XB_TOPGEN   3392
#define XCD_BAR_WORDS 3456
#define XB_SPIN_CAP (1u << 20)
DI unsigned xb_ld(unsigned* p)              { return __hip_atomic_load(p, __ATOMIC_RELAXED, __HIP_MEMORY_SCOPE_AGENT); }
DI unsigned xb_add(unsigned* p, unsigned v) { return __hip_atomic_fetch_add(p, v, __ATOMIC_RELAXED, __HIP_MEMORY_SCOPE_AGENT); }
DI unsigned xb_xcc_id() { return (unsigned)__builtin_amdgcn_s_getreg((3 << 11) | 20) & 0xFu; }
#define XB_SPIN(cond, bar) do { unsigned _sp = 0; while (cond) { __builtin_amdgcn_s_sleep(1); \
    if ((++_sp & 255u) == 0u) { if (xb_ld(&(bar)[XB_TMO])) break; if (_sp > XB_SPIN_CAP) { atomicAdd(&(bar)[XB_TMO], 1u); break; } } } } while (0)
struct XcdBarrier { unsigned* bar; unsigned x; volatile LAS unsigned* st; };
DI XcdBarrier xcd_barrier_post(unsigned* bar, volatile LAS unsigned* st) {
    XcdBarrier b; b.bar = bar; b.x = xb_xcc_id(); b.st = st;
    if (threadIdx.x == 0) st[2] = xb_add(&bar[XB_XCNT(b.x)], 1u);
    return b;
}
DI void xcd_barrier_complete(unsigned* bar, unsigned x, unsigned& nloc, unsigned& nx) {
    const unsigned G = gridDim.x * gridDim.y * gridDim.z;
    unsigned sum, cnt, mine, sp = 0u;
    for (;;) {
        sum = 0u; cnt = 0u; mine = 0u;
#pragma unroll
        for (unsigned j = 0; j < 16; ++j) { const unsigned c = xb_ld(&bar[XB_XCNT(j)]); sum += c; cnt += (c > 0u) ? 1u : 0u; mine = (j == x) ? c : mine; }
        if (sum == G) break;
        __builtin_amdgcn_s_sleep(1);
        if ((++sp & 255u) == 0u) { if (xb_ld(&bar[XB_TMO])) break; if (sp > XB_SPIN_CAP) { atomicAdd(&bar[XB_TMO], 1u); break; } }
    }
    nloc = mine > 0u ? mine : 1u; nx = cnt > 0u ? cnt : 1u;
}
DI void xcd_barrier(const XcdBarrier& b) {
    asm volatile("s_waitcnt vmcnt(0)" ::: "memory");
    __syncthreads();
    if (threadIdx.x == 0) {
        unsigned* bar = b.bar;
        __builtin_amdgcn_s_waitcnt(0);
        unsigned nloc = b.st[0], nx = b.st[1];
        if (nloc == 0u) { xcd_barrier_complete(bar, b.x, nloc, nx); b.st[0] = nloc; b.st[1] = nx; }
        const unsigned old = xb_add(&bar[XB_XSUB(b.x)], 1u);
        const unsigned gen = old / nloc;
        if (old + 1u == (gen + 1u) * nloc) {
            __builtin_amdgcn_fence(__ATOMIC_RELEASE, "agent");
            asm volatile("s_waitcnt vmcnt(0)" ::: "memory");
            const unsigned og = xb_add(&bar[XB_TOP], 1u);
            const unsigned tg = og / nx;
            if (og + 1u == (tg + 1u) * nx) xb_add(&bar[XB_TOPGEN], 1u);
            else XB_SPIN(xb_ld(&bar[XB_TOPGEN]) == tg, bar);
            __builtin_amdgcn_fence(__ATOMIC_ACQUIRE, "agent");
            xb_add(&bar[XB_XGEN(b.x)], 1u);
            asm volatile("s_waitcnt vmcnt(0)" ::: "memory");
        } else {
            XB_SPIN(xb_ld(&bar[XB_XGEN(b.x)]) == gen, bar);
            __builtin_amdgcn_fence(__ATOMIC_ACQUIRE, "agent");
            asm volatile("s_waitcnt vmcnt(0)" ::: "memory");
        }
    }
    __syncthreads();
}

struct Args {
    const float* x; const float* norm_w; const float* w_in; const float* conv_w; const float* conv_b;
    const float* dt_bias; const float* a_log; const float* d_skip; const float* ssd_norm_w; const float* w_out; const float* final_norm_w;
    float* out; unsigned char* ws; int ph_lo, ph_hi;
};

DI void conv_load(const bf16_t* proj, int t0, int l0, int cc, u32x4 (&raw)[7]) {
#pragma unroll
    for (int i = 0; i < 7; ++i) {
        const int t = t0 + l0 - 3 + i;
        if (t >= 0) raw[i] = *(const u32x4*)(proj + (size_t)t * NPROJ + XOFF + cc);
        else raw[i] = (u32x4){0u, 0u, 0u, 0u};
    }
}
DI void conv_compute(const u32x4 (&raw)[7], const float* cw, const float* cb, int cc, float (&out)[4][8]) {
    float w[4][8], b[8];
#pragma unroll
    for (int j = 0; j < 4; ++j) {
        const f32x4 w0 = *(const f32x4*)(cw + j * CONVD + cc), w1 = *(const f32x4*)(cw + j * CONVD + cc + 4);
        w[j][0] = w0[0]; w[j][1] = w0[1]; w[j][2] = w0[2]; w[j][3] = w0[3]; w[j][4] = w1[0]; w[j][5] = w1[1]; w[j][6] = w1[2]; w[j][7] = w1[3];
    }
    { const f32x4 b0 = *(const f32x4*)(cb + cc), b1 = *(const f32x4*)(cb + cc + 4);
      b[0] = b0[0]; b[1] = b0[1]; b[2] = b0[2]; b[3] = b0[3]; b[4] = b1[0]; b[5] = b1[1]; b[6] = b1[2]; b[7] = b1[3]; }
#pragma unroll
    for (int i = 0; i < 4; ++i)
#pragma unroll
        for (int e = 0; e < 8; ++e) {
            float a = b[e];
#pragma unroll
            for (int j = 0; j < 4; ++j) {
                const unsigned wd = raw[i + j][e >> 1];
                a += w[j][e] * ((e & 1) ? bf_hi(wd) : bf_lo(wd));
            }
            out[i][e] = silu_f(a);
        }
}

DI void head_dt(const float* dtraw, const float* dt_bias, const float* a_log, int t0, int h, int lane, float& dtv, float& acum) {
    const float xr = dtraw[(size_t)(t0 + lane) * 32 + h] + dt_bias[h];
    dtv = (xr > 20.f) ? xr : log1pf(expf(xr));
    const float A = -expf(a_log[h]);
    float v = dtv * A;
#pragma unroll
    for (int o = 1; o < 64; o <<= 1) { const float t = __shfl_up(v, o); if (lane >= o) v += t; }
    acum = v;
}

DI void transpose_item(const float* W, int Nsrc, int k0, int n0, const float* nw, bf16_t* dst, int Kdst, LAS float* scr, int lane) {
    f32x4 v[16]; float sc[16];
#pragma unroll
    for (int i = 0; i < 16; ++i) {
        const int kk = 8 * i + (lane >> 3);
        v[i] = __builtin_nontemporal_load((const f32x4*)(W + (size_t)(k0 + kk) * Nsrc + n0 + 4 * (lane & 7)));
        sc[i] = nw ? nw[k0 + kk] : 1.0f;
    }
#pragma unroll
    for (int i = 0; i < 16; ++i) {
        const int kk = 8 * i + (lane >> 3);
        LAS float* p = scr + kk * 33 + 4 * (lane & 7);
        p[0] = v[i][0] * sc[i]; p[1] = v[i][1] * sc[i]; p[2] = v[i][2] * sc[i]; p[3] = v[i][3] * sc[i];
    }
    asm volatile("s_waitcnt lgkmcnt(0)" ::: "memory");
    const int c = lane & 15;
#pragma unroll
    for (int j = 0; j < 8; ++j) {
        const int n = (lane >> 4) + 4 * j; const LAS float* s = scr + (8 * c) * 33 + n;
        u32x4 o; o.x = pk2(s[0 * 33], s[1 * 33]); o.y = pk2(s[2 * 33], s[3 * 33]); o.z = pk2(s[4 * 33], s[5 * 33]); o.w = pk2(s[6 * 33], s[7 * 33]);
        *(u32x4*)(dst + (size_t)n * Kdst + k0 + 8 * c) = o;
    }
    asm volatile("s_waitcnt lgkmcnt(0)" ::: "memory");
}

constexpr int CV_IN_ITEMS = 16 * 417, CV_OUT_ITEMS = 32 * 64, CV_PER_L = CV_IN_ITEMS + CV_OUT_ITEMS;
#ifndef CV_SLOT_N
#define CV_SLOT_N 8720
#endif
constexpr int CV_SLOT = CV_SLOT_N;
DI void convert_item(const Args& a, int l, int r, LAS float* scr, int lane) {
    bf16_t* win = (bf16_t*)(a.ws + WS_WIN); bf16_t* wdt = (bf16_t*)(a.ws + WS_WDT); bf16_t* wout = (bf16_t*)(a.ws + WS_WOUT);
    if (r < CV_IN_ITEMS) {
        const int nb = r % 417, kb = r / 417; const int n0 = nb * 32;
        bf16_t* dst;
        if (nb < 160) dst = win + ((size_t)l * NPROJ + n0) * DM;
        else if (nb == 160) dst = wdt + (size_t)l * 32 * DM;
        else dst = win + ((size_t)l * NPROJ + n0 - 32) * DM;
        transpose_item(a.w_in + (size_t)l * DM * INCOLS, INCOLS, kb * 128, n0, a.norm_w + l * DM, dst, DM, scr, lane);
    } else {
        r -= CV_IN_ITEMS; const int nb = r % 64, kb = r / 64;
        transpose_item(a.w_out + (size_t)l * DMIX * DM, DM, kb * 128, nb * 32, nullptr, wout + ((size_t)l * DM + nb * 32) * DMIX, DMIX, scr, lane);
    }
}

DI void phase_prologue(const Args& a, LAS unsigned char* lds) {
    const int tid = opaque_tid(), lane = tid & 63, wave = tid >> 6;
    const int gw = blockIdx.x * 8 + wave, NGW = gridDim.x * 8;
    LAS float* scr = (LAS float*)(lds + wave * 16896);
    constexpr int PRO_ITEMS = CV_PER_L + (NL - 1) * (CV_PER_L - CV_SLOT);
    for (int it = gw; it < PRO_ITEMS; it += NGW) {
        if (it < CV_PER_L) convert_item(a, 0, it, scr, lane);
        else { const int j = it - CV_PER_L; convert_item(a, 1 + j / (CV_PER_L - CV_SLOT), j % (CV_PER_L - CV_SLOT), scr, lane); }
    }
    bf16_t* xb = (bf16_t*)(a.ws + WS_XB); float* ssp = (float*)(a.ws + WS_SSP);
    for (int row = gw; row < S; row += NGW) {
        const f32x4* xr = (const f32x4*)(a.x + (size_t)row * DM) + lane;
        float ss = 0.f;
#pragma unroll
        for (int j = 0; j < 8; ++j) {
            const f32x4 v = xr[64 * j];
            ss += (v[0] * v[0] + v[1] * v[1]) + (v[2] * v[2] + v[3] * v[3]);
            u32x2 pb; pb.x = pk2(v[0], v[1]); pb.y = pk2(v[2], v[3]);
            *(u32x2*)(xb + (size_t)row * DM + 256 * j + 4 * lane) = pb;
        }
#pragma unroll
        for (int o = 1; o < 64; o <<= 1) ss += __shfl_xor(ss, o);
        if (lane < 8) ssp[lane * S + row] = (lane == 0) ? ss : 0.f;
    }
}

DI void dt_gemm(const Args& a, int layer, int blk, int nblk, LAS unsigned char* lds) {
    const int tid = opaque_tid(), lane = tid & 63, wave = tid >> 6, fr = lane & 15, q4 = lane >> 4;
    const bf16_t* xb = (const bf16_t*)(a.ws + WS_XB); const bf16_t* wdt = (const bf16_t*)(a.ws + WS_WDT) + (size_t)layer * 32 * DM;
    const float* ssp = (const float*)(a.ws + WS_SSP); float* dtraw = (float*)(a.ws + WS_DTRAW);
    LAS float* P = (LAS float*)lds;
    for (int tg = blk; tg < S / 64; tg += nblk) {
        const int row0 = tg * 64, kw = wave * 256;
        bf16x8 b0[8], b1[8];
#pragma unroll
        for (int ks = 0; ks < 8; ++ks) {
            b0[ks] = *(const bf16x8*)(wdt + (size_t)fr * DM + kw + ks * 32 + q4 * 8);
            b1[ks] = *(const bf16x8*)(wdt + (size_t)(16 + fr) * DM + kw + ks * 32 + q4 * 8);
        }
#pragma unroll
        for (int t = 0; t < 4; ++t) {
            bf16x8 av[8];
#pragma unroll
            for (int ks = 0; ks < 8; ++ks) av[ks] = *(const bf16x8*)(xb + (size_t)(row0 + 16 * t + fr) * DM + kw + ks * 32 + q4 * 8);
            f32x4 acc0 = {0.f, 0.f, 0.f, 0.f}, acc1 = {0.f, 0.f, 0.f, 0.f};
#pragma unroll
            for (int ks = 0; ks < 8; ++ks) { acc0 = mfma16(av[ks], b0[ks], acc0); acc1 = mfma16(av[ks], b1[ks], acc1); }
#pragma unroll
            for (int r = 0; r < 4; ++r) { P[(((wave * 4 + t) * 2 + 0) * 4 + r) * 64 + lane] = acc0[r]; P[(((wave * 4 + t) * 2 + 1) * 4 + r) * 64 + lane] = acc1[r]; }
        }
        __syncthreads();
#pragma unroll
        for (int i = 0; i < 4; ++i) {
            const int o = tid + 512 * i;
            const int ln = o & 63, r = (o >> 6) & 3, j = (o >> 8) & 1, t = o >> 9;
            float sum = 0.f;
#pragma unroll
            for (int w = 0; w < 8; ++w) sum += P[w * 2048 + o];
            const int row = row0 + 16 * t + 4 * (ln >> 4) + r;
            dtraw[(size_t)row * 32 + 16 * j + (ln & 15)] = sum * row_rstd(ssp, row);
        }
        __syncthreads();
    }
}

constexpr int TS = 136, XS_STR = 520;
DI void ssd_states_unit(const Args& a, int layer, int c, int g, LAS unsigned char* lds) {
    const int tid = opaque_tid(), lane = tid & 63, wave = tid >> 6, fr = lane & 15, q4 = lane >> 4;
    const int t0 = c * 64, h = g * 8 + wave;
    const bf16_t* proj = (const bf16_t*)(a.ws + WS_PROJ);
    bf16_t* xact = (bf16_t*)(a.ws + WS_XACT);
    LAS unsigned char* BS = lds;
    LAS unsigned char* XS = lds + 64 * TS * 2;
    LAS float* WL = (LAS float*)(lds + 64 * TS * 2 + 64 * XS_STR * 2);
    {
        float dtv, ac;
        head_dt((const float*)(a.ws + WS_DTRAW), a.dt_bias + layer * NH, a.a_log + layer * NH, t0, h, lane, dtv, ac);
        const float alast = __shfl(ac, 63);
        WL[wave * 64 + lane] = __expf(alast - ac) * dtv;
        if (lane == 0) ((float*)(a.ws + WS_CDEC))[c * NH + h] = __expf(alast);
    }
    __syncthreads();
    const float* cw = a.conv_w + (size_t)layer * 4 * CONVD; const float* cb = a.conv_b + (size_t)layer * CONVD;
    u32x4 raw3[3][7];
#pragma unroll
    for (int k = 0; k < 3; ++k) {
        const int it = tid + 512 * k, cgi = it % 96, l0 = (it / 96) * 4;
        const int cc = (cgi < 64) ? g * 512 + cgi * 8 : (cgi < 80) ? 2048 + g * 128 + (cgi - 64) * 8 : 2560 + g * 128 + (cgi - 80) * 8;
        conv_load(proj, t0, l0, cc, raw3[k]);
    }
#pragma unroll
    for (int k = 0; k < 3; ++k) {
        const int it = tid + 512 * k;
        const int cgi = it % 96, l0 = (it / 96) * 4;
        const int cc = (cgi < 64) ? g * 512 + cgi * 8 : (cgi < 80) ? 2048 + g * 128 + (cgi - 64) * 8 : 2560 + g * 128 + (cgi - 80) * 8;
        float o[4][8];
        conv_compute(raw3[k], cw, cb, cc, o);
#pragma unroll
        for (int i = 0; i < 4; ++i) {
            u32x4 v; v.x = pk2(o[i][0], o[i][1]); v.y = pk2(o[i][2], o[i][3]); v.z = pk2(o[i][4], o[i][5]); v.w = pk2(o[i][6], o[i][7]);
            *(u32x4*)(xact + (size_t)(t0 + l0 + i) * CONVD + cc) = v;
            if (cgi >= 64 && cgi < 80) *(LAS u32x4*)(BS + ((l0 + i) * TS + (cgi - 64) * 8) * 2) = v;
        }
        if (cgi < 64) {
            const int hd = cgi >> 3;
#pragma unroll
            for (int i = 0; i < 4; ++i) {
                const float w = WL[hd * 64 + l0 + i];
                u32x4 v; v.x = pk2(o[i][0] * w, o[i][1] * w); v.y = pk2(o[i][2] * w, o[i][3] * w); v.z = pk2(o[i][4] * w, o[i][5] * w); v.w = pk2(o[i][6] * w, o[i][7] * w);
                *(LAS u32x4*)(XS + ((l0 + i) * XS_STR + cgi * 8) * 2) = v;
            }
        }
    }
    __syncthreads();
    f32x4 acc[8][4];
#pragma unroll
    for (int nb = 0; nb < 8; ++nb)
#pragma unroll
        for (int pb = 0; pb < 4; ++pb) acc[nb][pb] = (f32x4){0.f, 0.f, 0.f, 0.f};
#pragma unroll
    for (int ks = 0; ks < 2; ++ks) {
        bf16x8 xf[4];
#pragma unroll
        for (int pb = 0; pb < 4; ++pb) xf[pb] = tr_frag(XS, XS_STR, ks * 32 + q4 * 8, wave * 64 + pb * 16, fr);
#pragma unroll
        for (int nb = 0; nb < 8; ++nb) {
            const bf16x8 bfr = tr_frag(BS, TS, ks * 32 + q4 * 8, nb * 16, fr);
#pragma unroll
            for (int pb = 0; pb < 4; ++pb) acc[nb][pb] = mfma16(bfr, xf[pb], acc[nb][pb]);
        }
    }
    bf16_t* st = (bf16_t*)(a.ws + WS_STATES) + ((size_t)(c * NH + h) * 64) * 128;
#pragma unroll
    for (int nb = 0; nb < 8; ++nb)
#pragma unroll
        for (int pb = 0; pb < 4; ++pb) {
            u32x2 v; v.x = pk2(acc[nb][pb][0], acc[nb][pb][1]); v.y = pk2(acc[nb][pb][2], acc[nb][pb][3]);
            *(u32x2*)(st + (size_t)(pb * 16 + fr) * 128 + nb * 16 + 4 * q4) = v;
        }
    __syncthreads();
}

DI void phase_scan(const Args& a, unsigned char* states_base) {
    const int gt = blockIdx.x * 512 + opaque_tid(), NT = gridDim.x * 512;
    unsigned* st = (unsigned*)states_base; const float* cdec = (const float*)(a.ws + WS_CDEC);
    constexpr int PAIRS = NH * 64 * 128 / 2;
    for (int e = gt; e < PAIRS; e += NT) {
        const int h = e >> 12;
        float r0 = 0.f, r1 = 0.f;
        for (int c0 = 0; c0 < NCHUNK; c0 += 8) {
            unsigned v[8]; float d[8];
#pragma unroll
            for (int j = 0; j < 8; ++j) { v[j] = st[(size_t)(c0 + j) * PAIRS + e]; d[j] = cdec[(c0 + j) * NH + h]; }
#pragma unroll
            for (int j = 0; j < 8; ++j) {
                st[(size_t)(c0 + j) * PAIRS + e] = pk2(r0, r1);
                r0 = r0 * d[j] + bf_lo(v[j]); r1 = r1 * d[j] + bf_hi(v[j]);
            }
        }
    }
}

DI void ssd_out_unit(const Args& a, int layer, int c, int g, LAS unsigned char* lds) {
    const int tid = opaque_tid(), lane = tid & 63, wave = tid >> 6, fr = lane & 15, q4 = lane >> 4;
    const int t0 = c * 64, h = g * 8 + wave;
    const bf16_t* proj = (const bf16_t*)(a.ws + WS_PROJ);
    const bf16_t* xact = (const bf16_t*)(a.ws + WS_XACT);
    LAS unsigned char* CS = lds;
    LAS unsigned char* BS = lds + 64 * TS * 2;
    LAS unsigned char* XS = lds + 2 * 64 * TS * 2;
    LAS float* GS = (LAS float*)(lds + 2 * 64 * TS * 2 + 64 * XS_STR * 2);
    LAS float* DTS = GS + 64 * 68;
    LAS float* ACS = DTS + 512;
    LAS float* SSQ = ACS + 512;
    const bf16_t* prev = (const bf16_t*)(a.ws + WS_STATES) + ((size_t)(c * NH + h) * 64) * 128;
    bf16x8 pf[4][4];
#pragma unroll
    for (int ks = 0; ks < 4; ++ks)
#pragma unroll
        for (int pb = 0; pb < 4; ++pb) pf[ks][pb] = *(const bf16x8*)(prev + (size_t)(pb * 16 + fr) * 128 + ks * 32 + q4 * 8);
    u32x2 zr[4][4];
#pragma unroll
    for (int lb = 0; lb < 4; ++lb)
#pragma unroll
        for (int pb = 0; pb < 4; ++pb) zr[lb][pb] = *(const u32x2*)(proj + (size_t)(t0 + lb * 16 + fr) * NPROJ + ZOFF + h * 64 + pb * 16 + 4 * q4);
    {
        float dtv, ac;
        head_dt((const float*)(a.ws + WS_DTRAW), a.dt_bias + layer * NH, a.a_log + layer * NH, t0, h, lane, dtv, ac);
        DTS[wave * 64 + lane] = dtv; ACS[wave * 64 + lane] = ac;
    }
    {
        u32x4 xv[8], bv[2], cv[2];
#pragma unroll
        for (int i = 0; i < 8; ++i) { const int piece = tid + 512 * i, row = piece >> 6, ch = piece & 63; xv[i] = *(const u32x4*)(xact + (size_t)(t0 + row) * CONVD + g * 512 + ch * 8); }
#pragma unroll
        for (int i = 0; i < 2; ++i) { const int piece = tid + 512 * i, row = piece >> 4, ch = piece & 15;
            bv[i] = *(const u32x4*)(xact + (size_t)(t0 + row) * CONVD + 2048 + g * 128 + ch * 8); cv[i] = *(const u32x4*)(xact + (size_t)(t0 + row) * CONVD + 2560 + g * 128 + ch * 8); }
#pragma unroll
        for (int i = 0; i < 8; ++i) { const int piece = tid + 512 * i, row = piece >> 6, ch = piece & 63; *(LAS u32x4*)(XS + (row * XS_STR + ch * 8) * 2) = xv[i]; }
#pragma unroll
        for (int i = 0; i < 2; ++i) { const int piece = tid + 512 * i, row = piece >> 4, ch = piece & 15;
            *(LAS u32x4*)(BS + (row * TS + ch * 8) * 2) = bv[i]; *(LAS u32x4*)(CS + (row * TS + ch * 8) * 2) = cv[i]; }
    }
    __syncthreads();
    {
        const int lb = wave >> 1;
#pragma unroll
        for (int sj = 0; sj < 2; ++sj) {
            const int sb = 2 * (wave & 1) + sj;
            f32x4 gacc = {0.f, 0.f, 0.f, 0.f};
#pragma unroll
            for (int ks = 0; ks < 4; ++ks) {
                const bf16x8 cf = *(const LAS bf16x8*)(CS + ((lb * 16 + fr) * TS + ks * 32 + q4 * 8) * 2);
                const bf16x8 bfr = *(const LAS bf16x8*)(BS + ((sb * 16 + fr) * TS + ks * 32 + q4 * 8) * 2);
                gacc = mfma16(cf, bfr, gacc);
            }
#pragma unroll
            for (int r = 0; r < 4; ++r) GS[(lb * 16 + 4 * q4 + r) * 68 + sb * 16 + fr] = gacc[r];
        }
    }
    __syncthreads();
    f32x4 acc[4][4];
#pragma unroll
    for (int pb = 0; pb < 4; ++pb)
#pragma unroll
        for (int lb = 0; lb < 4; ++lb) acc[pb][lb] = (f32x4){0.f, 0.f, 0.f, 0.f};
#pragma unroll
    for (int ks = 0; ks < 4; ++ks) {
        bf16x8 cf[4];
#pragma unroll
        for (int lb = 0; lb < 4; ++lb) cf[lb] = *(const LAS bf16x8*)(CS + ((lb * 16 + fr) * TS + ks * 32 + q4 * 8) * 2);
#pragma unroll
        for (int pb = 0; pb < 4; ++pb)
#pragma unroll
            for (int lb = 0; lb < 4; ++lb) acc[pb][lb] = mfma16(pf[ks][pb], cf[lb], acc[pb][lb]);
    }
    float acl[4];
#pragma unroll
    for (int lb = 0; lb < 4; ++lb) {
        acl[lb] = ACS[wave * 64 + lb * 16 + fr];
        const float el = __expf(acl[lb]);
#pragma unroll
        for (int pb = 0; pb < 4; ++pb) acc[pb][lb] *= el;
    }
    const float Dh = a.d_skip[layer * NH + h];
#pragma unroll
    for (int ks2 = 0; ks2 < 2; ++ks2) {
        float as8[8], ds8[8];
        {
            const f32x4 a0 = *(const LAS f32x4*)(ACS + wave * 64 + ks2 * 32 + q4 * 8), a1 = *(const LAS f32x4*)(ACS + wave * 64 + ks2 * 32 + q4 * 8 + 4);
            const f32x4 d0 = *(const LAS f32x4*)(DTS + wave * 64 + ks2 * 32 + q4 * 8), d1 = *(const LAS f32x4*)(DTS + wave * 64 + ks2 * 32 + q4 * 8 + 4);
#pragma unroll
            for (int j = 0; j < 4; ++j) { as8[j] = a0[j]; as8[4 + j] = a1[j]; ds8[j] = d0[j]; ds8[4 + j] = d1[j]; }
        }
        bf16x8 xf[4];
#pragma unroll
        for (int pb = 0; pb < 4; ++pb) xf[pb] = tr_frag(XS, XS_STR, ks2 * 32 + q4 * 8, wave * 64 + pb * 16, fr);
#pragma unroll
        for (int lb = 0; lb < 4; ++lb) {
            if (ks2 * 32 > lb * 16 + 15) continue;
            const int l = lb * 16 + fr;
            const f32x4 g0 = *(const LAS f32x4*)(GS + l * 68 + ks2 * 32 + q4 * 8), g1 = *(const LAS f32x4*)(GS + l * 68 + ks2 * 32 + q4 * 8 + 4);
            float mv[8];
#pragma unroll
            for (int j = 0; j < 8; ++j) {
                const int s_ = ks2 * 32 + q4 * 8 + j;
                const float gv = (j < 4) ? g0[j & 3] : g1[j & 3];
                float v = (s_ <= l) ? gv * __expf(acl[lb] - as8[j]) * ds8[j] : 0.f;
                if (s_ == l) v += Dh;
                mv[j] = v;
            }
            u32x4 mp; mp.x = pk2(mv[0], mv[1]); mp.y = pk2(mv[2], mv[3]); mp.z = pk2(mv[4], mv[5]); mp.w = pk2(mv[6], mv[7]);
            const bf16x8 mf = __builtin_bit_cast(bf16x8, mp);
#pragma unroll
            for (int pb = 0; pb < 4; ++pb) acc[pb][lb] = mfma16(xf[pb], mf, acc[pb][lb]);
        }
    }
#pragma unroll
    for (int lb = 0; lb < 4; ++lb) {
        const int l = lb * 16 + fr; float ss = 0.f;
#pragma unroll
        for (int pb = 0; pb < 4; ++pb) {
            const u32x2 z2 = zr[lb][pb];
            f32x4 y = acc[pb][lb];
            y[0] *= silu_f(bf_lo(z2.x)); y[1] *= silu_f(bf_hi(z2.x)); y[2] *= silu_f(bf_lo(z2.y)); y[3] *= silu_f(bf_hi(z2.y));
            acc[pb][lb] = y;
            ss += (y[0] * y[0] + y[1] * y[1]) + (y[2] * y[2] + y[3] * y[3]);
        }
        ss += __shfl_xor(ss, 16); ss += __shfl_xor(ss, 32);
        if (q4 == 0) SSQ[wave * 64 + l] = ss;
    }
    __syncthreads();
    bf16_t* mix = (bf16_t*)(a.ws + WS_MIX);
    const float* nw = a.ssd_norm_w + (size_t)layer * 2048 + h * 64;
    f32x4 wv[4];
#pragma unroll
    for (int pb = 0; pb < 4; ++pb) wv[pb] = *(const f32x4*)(nw + pb * 16 + 4 * q4);
#pragma unroll
    for (int lb = 0; lb < 4; ++lb) {
        const int l = lb * 16 + fr; float tot = 0.f;
#pragma unroll
        for (int w2 = 0; w2 < 8; ++w2) tot += SSQ[w2 * 64 + l];
        const float rs = rsqrtf(tot * (1.0f / 512.0f) + EPS);
#pragma unroll
        for (int pb = 0; pb < 4; ++pb) {
            const f32x4 y = acc[pb][lb];
            u32x2 o; o.x = pk2(y[0] * rs * wv[pb][0], y[1] * rs * wv[pb][1]); o.y = pk2(y[2] * rs * wv[pb][2], y[3] * rs * wv[pb][3]);
            *(u32x2*)(mix + (size_t)(t0 + l) * DMIX + h * 64 + pb * 16 + 4 * q4) = o;
        }
    }
    __syncthreads();
}

typedef float f32x2 __attribute__((ext_vector_type(2)));
template <bool MASK> DI void sb_block(const f32x4& zacc, float scale2, int s0, int t, float m1, float m2, float& R, unsigned& w0, unsigned& w1) {
    const f32x2 za = (f32x2){zacc[0], zacc[1]} * scale2, zb = (f32x2){zacc[2], zacc[3]} * scale2;
    f32x2 ea, eb;
    ea.x = __builtin_amdgcn_exp2f(-fabsf(za.x)); ea.y = __builtin_amdgcn_exp2f(-fabsf(za.y)); eb.x = __builtin_amdgcn_exp2f(-fabsf(zb.x)); eb.y = __builtin_amdgcn_exp2f(-fabsf(zb.y));
    const f32x2 ua = ea + 1.0f, ub = eb + 1.0f;
    f32x2 la, lb, ma, mb;
    la.x = __builtin_amdgcn_logf(ua.x); la.y = __builtin_amdgcn_logf(ua.y); lb.x = __builtin_amdgcn_logf(ub.x); lb.y = __builtin_amdgcn_logf(ub.y);
    ma.x = fmaxf(za.x, 0.f); ma.y = fmaxf(za.y, 0.f); mb.x = fmaxf(zb.x, 0.f); mb.y = fmaxf(zb.y, 0.f);
    f32x2 spa = ma + la, spb = mb + lb;
    bool v0 = true, v1 = true, v2 = true, v3 = true;
    if (MASK) { v0 = s0 < t; v1 = s0 + 1 < t; v2 = s0 + 2 < t; v3 = s0 + 3 < t;
        spa.x = v0 ? spa.x : 0.f; spa.y = v1 ? spa.y : 0.f; spb.x = v2 ? spb.x : 0.f; spb.y = v3 ? spb.y : 0.f; }
    const float suf3 = spb.y, suf2 = spb.x + suf3, suf1 = spa.y + suf2, suf0 = spa.x + suf1;
    const auto s16 = __builtin_amdgcn_permlane16_swap(__float_as_uint(suf0), __float_as_uint(suf0), false, false);
    const float po = __uint_as_float(s16[1]);
    const float psum = __uint_as_float(s16[0]) + po;
    const auto s32 = __builtin_amdgcn_permlane32_swap(__float_as_uint(psum), __float_as_uint(psum), false, false);
    const float hlo = __uint_as_float(s32[0]), hhi = __uint_as_float(s32[1]);
    const float nb = -(R + (m1 * po + m2 * hhi));
    R += hlo + hhi;
    const f32x2 aa = (za + nb) - (f32x2){suf0, suf1}, ab = (zb + nb) - (f32x2){suf2, suf3};
    float x0 = __builtin_amdgcn_exp2f(aa.x), x1 = __builtin_amdgcn_exp2f(aa.y), x2 = __builtin_amdgcn_exp2f(ab.x), x3 = __builtin_amdgcn_exp2f(ab.y);
    if (MASK) { x0 = v0 ? x0 : 0.f; x1 = v1 ? x1 : 0.f; x2 = v2 ? x2 : 0.f; x3 = v3 ? x3 : 0.f; }
    w0 = pk2(x0, x1); w1 = pk2(x2, x3);
}

constexpr int NTB = 1, ATT_Q = 128 * NTB;
DI void attn_unit(const Args& a, int h, int qb, LAS unsigned char* lds) {
    const int tid = opaque_tid(), lane = tid & 63, wave = tid >> 6, fr = lane & 15, q4 = lane >> 4;
    const bf16_t* proj = (const bf16_t*)(a.ws + WS_PROJ);
    constexpr int KVB = 64 * TS * 2;
    LAS int* FLG = (LAS int*)(lds + 4 * KVB);
    const int q0 = qb * ATT_Q, tq0 = q0 + wave * 16 * NTB, tmax = tq0 + 16 * NTB - 2;
    const float scale2 = 0.08838834764831845f * 1.4426950408889634f;
    constexpr float THR2 = 151.0f;
    bf16x8 qf[NTB][4];
#pragma unroll
    for (int tb = 0; tb < NTB; ++tb)
#pragma unroll
        for (int ks = 0; ks < 4; ++ks) qf[tb][ks] = *(const bf16x8*)(proj + (size_t)(tq0 + tb * 16 + fr) * NPROJ + QOFF + h * 128 + ks * 32 + q4 * 8);
    f32x4 oacc[NTB][8];
    u32x2 gpre[NTB][8];
#pragma unroll
    for (int tb = 0; tb < NTB; ++tb)
#pragma unroll
        for (int db = 0; db < 8; ++db) {
            oacc[tb][db] = (f32x4){0.f, 0.f, 0.f, 0.f};
            gpre[tb][db] = *(const u32x2*)(proj + (size_t)(tq0 + tb * 16 + fr) * NPROJ + GOFF + h * 128 + db * 16 + 4 * q4);
        }
    float R[NTB];
#pragma unroll
    for (int tb = 0; tb < NTB; ++tb) R[tb] = 0.f;
    const float m1 = (q4 & 1) ? 0.f : 1.f, m2 = (q4 < 2) ? 1.f : 0.f;
    bool fin = false;
    int b = 0;
    const int kt_top = (q0 + ATT_Q - 1) >> 6;
    u32x4 kreg[2], vreg[2];
    const int prow = tid >> 4, pch = tid & 15;
    {
        const bf16_t* src = proj + (size_t)(kt_top * 64 + prow) * NPROJ + h * 128 + pch * 8;
        kreg[0] = *(const u32x4*)(src + KOFF); vreg[0] = *(const u32x4*)(src + VOFF);
        kreg[1] = *(const u32x4*)(src + (size_t)32 * NPROJ + KOFF); vreg[1] = *(const u32x4*)(src + (size_t)32 * NPROJ + VOFF);
    }
    for (int kt = kt_top; kt >= 0; --kt) {
        const int k0 = kt * 64;
        LAS unsigned char* KS = lds + b * 2 * KVB; LAS unsigned char* VS = KS + KVB;
        *(LAS u32x4*)(KS + (prow * TS + pch * 8) * 2) = kreg[0]; *(LAS u32x4*)(KS + ((prow + 32) * TS + pch * 8) * 2) = kreg[1];
        *(LAS u32x4*)(VS + (prow * TS + pch * 8) * 2) = vreg[0]; *(LAS u32x4*)(VS + ((prow + 32) * TS + pch * 8) * 2) = vreg[1];
        if (lane == 0) FLG[b * 8 + wave] = fin ? 1 : 0;
        __syncthreads();
        int allfin = 1;
#pragma unroll
        for (int w2 = 0; w2 < 8; ++w2) allfin &= FLG[b * 8 + w2];
        if (allfin) break;
        if (kt > 0) {
            const bf16_t* src = proj + (size_t)(k0 - 64 + prow) * NPROJ + h * 128 + pch * 8;
            kreg[0] = *(const u32x4*)(src + KOFF); vreg[0] = *(const u32x4*)(src + VOFF);
            kreg[1] = *(const u32x4*)(src + (size_t)32 * NPROJ + KOFF); vreg[1] = *(const u32x4*)(src + (size_t)32 * NPROJ + VOFF);
        }
        if (!fin && k0 <= tmax) {
#pragma unroll
            for (int kk = 1; kk >= 0; --kk) {
                u32x4 wp[NTB];
#pragma unroll
                for (int tb = 0; tb < NTB; ++tb) wp[tb] = (u32x4){0u, 0u, 0u, 0u};
                bool any = false;
#pragma unroll
                for (int half = 1; half >= 0; --half) {
                    const int kb = 2 * kk + half, kbase = k0 + 16 * kb;
                    if (fin || kbase > tmax) continue;
                    any = true;
                    f32x4 z[NTB];
#pragma unroll
                    for (int tb = 0; tb < NTB; ++tb) z[tb] = (f32x4){0.f, 0.f, 0.f, 0.f};
#pragma unroll
                    for (int ks = 0; ks < 4; ++ks) {
                        const bf16x8 kf = *(const LAS bf16x8*)(KS + ((kb * 16 + fr) * TS + ks * 32 + q4 * 8) * 2);
#pragma unroll
                        for (int tb = 0; tb < NTB; ++tb) z[tb] = mfma16(kf, qf[tb][ks], z[tb]);
                    }
                    bool ok = true;
#pragma unroll
                    for (int tb = 0; tb < NTB; ++tb) {
                        const int t = tq0 + tb * 16 + fr;
                        unsigned w0, w1;
                        sb_block<true>(z[tb], scale2, kbase + 4 * q4, t, m1, m2, R[tb], w0, w1);
                        if (half == 0) { wp[tb].x = w0; wp[tb].y = w1; } else { wp[tb].z = w0; wp[tb].w = w1; }
                        ok = ok && (R[tb] >= THR2);
                    }
                    fin = __all(ok);
                }
                if (any) {
#pragma unroll
                    for (int db = 0; db < 8; ++db) {
                        LAS unsigned char* vp = VS + ((kk * 32 + 4 * q4 + (fr >> 2)) * TS + db * 16 + 4 * (fr & 3)) * 2;
                        const s16x4 lo = __builtin_amdgcn_ds_read_tr16_b64_v4i16((LAS s16x4*)vp);
                        const s16x4 hi = __builtin_amdgcn_ds_read_tr16_b64_v4i16((LAS s16x4*)(vp + 16 * TS * 2));
                        bf16x8 vf; vf[0] = lo[0]; vf[1] = lo[1]; vf[2] = lo[2]; vf[3] = lo[3]; vf[4] = hi[0]; vf[5] = hi[1]; vf[6] = hi[2]; vf[7] = hi[3];
#pragma unroll
                        for (int tb = 0; tb < NTB; ++tb) oacc[tb][db] = mfma16(vf, __builtin_bit_cast(bf16x8, wp[tb]), oacc[tb][db]);
                    }
                }
            }
        }
        b ^= 1;
    }
    bf16_t* mix = (bf16_t*)(a.ws + WS_MIX);
#pragma unroll
    for (int tb = 0; tb < NTB; ++tb) {
        const int t = tq0 + tb * 16 + fr;
#pragma unroll
        for (int db = 0; db < 8; ++db) {
            const u32x2 gr = gpre[tb][db];
            const f32x4 o = oacc[tb][db];
            u32x2 ov; ov.x = pk2(o[0] * silu_f(bf_lo(gr.x)), o[1] * silu_f(bf_hi(gr.x))); ov.y = pk2(o[2] * silu_f(bf_lo(gr.y)), o[3] * silu_f(bf_hi(gr.y)));
            *(u32x2*)(mix + (size_t)t * DMIX + 2048 + h * 128 + db * 16 + 4 * q4) = ov;
        }
    }
    __syncthreads();
}

DI void phase_final(const Args& a) {
    const int tid = opaque_tid(), lane = tid & 63, wave = tid >> 6;
    const int gw = blockIdx.x * 8 + wave, NGW = gridDim.x * 8;
    const bf16_t* xb = (const bf16_t*)(a.ws + WS_XB); const float* ssp = (const float*)(a.ws + WS_SSP);
    for (int row = gw; row < S; row += NGW) {
        const float rs = row_rstd(ssp, row);
        const u32x2* xr = (const u32x2*)(xb + (size_t)row * DM) + lane;
        const f32x4* wr = (const f32x4*)a.final_norm_w + lane;
        f32x4* orow = (f32x4*)(a.out + (size_t)row * DM) + lane;
#pragma unroll
        for (int j = 0; j < 8; ++j) {
            const u32x2 xv = xr[64 * j]; const f32x4 w = wr[64 * j];
            f32x4 o; o[0] = bf_lo(xv.x) * rs * w[0]; o[1] = bf_hi(xv.x) * rs * w[1]; o[2] = bf_lo(xv.y) * rs * w[2]; o[3] = bf_hi(xv.y) * rs * w[3];
            orow[64 * j] = o;
        }
    }
}

__global__ void __launch_bounds__(512, 2) hybrid_fwd(Args a) {
    extern __shared__ __attribute__((aligned(16))) unsigned char lds_raw[];
    LAS unsigned char* lds = (LAS unsigned char*)lds_raw;
    const int G = gridDim.x, bx = blockIdx.x;
    volatile LAS unsigned* bst = (volatile LAS unsigned*)(lds + LDS_BYTES - 16);
    if (threadIdx.x < 4) bst[threadIdx.x] = 0u;
    __syncthreads();
    XcdBarrier bar = xcd_barrier_post((unsigned*)(a.ws + WS_BAR), bst);
    __syncthreads();
    int vb = bx;
    int rep = 0;
    for (int ph = a.ph_lo; ph < a.ph_hi;) {
        int ptype;
        if (ph == 0) ptype = 1; else if (ph == NPHASE - 1) ptype = 512; else { const int sub = (ph - 1) % 5; ptype = sub == 0 ? 2 : sub == 1 ? (8 | 16) : sub == 2 ? 32 : sub == 3 ? 64 : 128; }
        const bool dummy = (DUPM & ptype) && rep == 0;
        if (ph == 0) {
#if !(SKIPM & 1)
            phase_prologue(a, lds);
#endif
        } else if (ph == NPHASE - 1) {
            phase_final(a);
        } else {
            const int layer = (ph - 1) / 5, sub = (ph - 1) % 5;
            if (sub == 0) {
                pg8::Gemm g; g.A = (const bf16_t*)(a.ws + WS_XB); g.Bt = (const bf16_t*)(a.ws + WS_WIN) + (size_t)layer * NPROJ * DM; g.M = S; g.N = NPROJ; g.K = DM;
                pg8::StaticOrder so; so.init(S, NPROJ, G, vb);
                pg8::EpiInProj e; e.O = (bf16_t*)(a.ws + WS_PROJ); e.ssp = (const float*)(a.ws + WS_SSP);
                {
                    pg8::Unit u0; u0.pm = 0; u0.pn = 0; so.next(0, u0);
                    LAS float* rsl = (LAS float*)(lds + pg8::STAGE_BYTES);
                    const int t_ = opaque_tid();
                    if (t_ < 256) rsl[t_] = row_rstd(e.ssp, u0.pm * 256 + t_);
                    e.rs_lds = rsl; e.pm0 = u0.pm;
                    __syncthreads();
                }
#if !(SKIPM & 2)
                pg8::gemm_phase(lds, g, so, e);
#endif
                const int nfull = (S / 256) * (NPROJ / 256);
                const int rem = nfull % G;
                const int wave = opaque_tid() >> 6;
#if !(SKIPM & 4)
                if (rem == 0 || G - rem < 64) dt_gemm(a, layer, vb, G, lds);
                else if (vb >= rem) dt_gemm(a, layer, vb - rem, G - rem, lds);
#endif
                if (layer + 1 < NL && !dummy) {
                    const int lane = opaque_tid() & 63;
                    LAS float* scr = (LAS float*)(lds + wave * 16896);
                    if (rem == 0 || G - rem < 64) { for (int it = CV_PER_L - CV_SLOT + vb * 8 + wave; it < CV_PER_L; it += G * 8) convert_item(a, layer + 1, it, scr, lane); }
                    else if (vb >= rem) { for (int it = CV_PER_L - CV_SLOT + (vb - rem) * 8 + wave; it < CV_PER_L; it += (G - rem) * 8) convert_item(a, layer + 1, it, scr, lane); }
                }
            } else if (sub == 1) {
#if !(SKIPM & 8)
                if (!(DUPM & 24) || !dummy || (DUPM & 8))
                for (int u = bx; u < 512; u += G) ssd_states_unit(a, layer, u >> 2, u & 3, lds);
#endif
#if !(SKIPM & 16)
                if (!(DUPM & 24) || !dummy || (DUPM & 16))
                for (int u = bx; u < 16 * (S / ATT_Q); u += G) attn_unit(a, u & 15, u >> 4, lds);
#endif
            } else if (sub == 2) {
#if !(SKIPM & 32)
                phase_scan(a, a.ws + (dummy ? WS_END : WS_STATES));
#endif
            } else if (sub == 3) {
#if !(SKIPM & 64)
                for (int u = bx; u < 512; u += G) ssd_out_unit(a, layer, u >> 2, u & 3, lds);
#endif
            } else {
                pg8::Gemm g; g.A = (const bf16_t*)(a.ws + WS_MIX); g.Bt = (const bf16_t*)(a.ws + WS_WOUT) + (size_t)layer * DM * DMIX; g.M = S; g.N = DM; g.K = DMIX;
                pg8::StaticOrder so; so.init(S, DM, G, vb);
                pg8::EpiOutProj e; e.xb = (bf16_t*)(a.ws + WS_XB); e.ssp = (float*)(a.ws + WS_SSP);
#if !(SKIPM & 128)
                pg8::gemm_phase(lds, g, so, e);
#endif
            }
        }
        if (dummy) rep = 1; else { rep = 0; ++ph; }
        if (ph < a.ph_hi) {
            if (ph == 1 && !dummy) {
                cg::this_grid().sync();
                if ((G & 7) == 0) {
                    bool uni = true;
                    for (unsigned j = 0; j < 8; ++j) uni = uni && (xb_ld(&bar.bar[XB_XCNT(j)]) == (unsigned)(G >> 3));
                    const unsigned rank = bst[2];
                    if (uni && rank < (unsigned)(G >> 3) && bar.x < 8u) vb = (int)(rank * 8u + bar.x);
                }
            } else xcd_barrier(bar);
        }
    }
#if (DUPM & 256)
    for (int i = 0; i < 20; ++i) cg::this_grid().sync();
#endif
}

extern "C" void kernel_launch(void* const* d_in, const int* in_sizes, int n_in, void* d_out, int out_size, void* d_ws, size_t ws_size, hipStream_t stream) {
    static int grid = 0;
    if (grid == 0) {
        if (n_in != 11 || out_size != S * DM || ws_size < WS_END) { fprintf(stderr, "kernel_launch: unexpected shapes (n_in %d out %d ws %zu need %zu)\n", n_in, out_size, ws_size, (size_t)WS_END); grid = -1; return; }
        int dev = 0, cus = 0, per_cu = 0;
        hipGetDevice(&dev);
        hipDeviceGetAttribute(&cus, hipDeviceAttributeMultiprocessorCount, dev);
        if (hipFuncSetAttribute((const void*)hybrid_fwd, hipFuncAttributeMaxDynamicSharedMemorySize, LDS_BYTES) != hipSuccess) { fprintf(stderr, "kernel_launch: hipFuncSetAttribute failed\n"); grid = -1; return; }
        hipOccupancyMaxActiveBlocksPerMultiprocessor(&per_cu, (const void*)hybrid_fwd, 512, LDS_BYTES);
        (void)hipGetLastError();
        if (per_cu < 1) { fprintf(stderr, "kernel_launch: occupancy query says %d blocks per CU\n", per_cu); per_cu = 1; }
        grid = cus;
        if (grid != 256) fprintf(stderr, "kernel_launch: %d CUs; this build assumes 256\n", grid);
    }
    if (grid < 0) return;
    Args a{};
    a.x = (const float*)d_in[0]; a.norm_w = (const float*)d_in[1]; a.w_in = (const float*)d_in[2]; a.conv_w = (const float*)d_in[3]; a.conv_b = (const float*)d_in[4];
    a.dt_bias = (const float*)d_in[5]; a.a_log = (const float*)d_in[6]; a.d_skip = (const float*)d_in[7]; a.ssd_norm_w = (const float*)d_in[8];
    a.w_out = (const float*)d_in[9]; a.final_norm_w = (const float*)d_in[10];
    a.out = (float*)d_out; a.ws = (unsigned char*)d_ws;
    if (hipMemsetAsync((char*)d_ws + WS_BAR, 0, 16384, stream) != hipSuccess) { fprintf(stderr, "kernel_launch: memset of the barrier words failed\n"); return; }
#if ONE_LAUNCH
    a.ph_lo = 0; a.ph_hi = NPHASE;
    void* args[] = {&a};
    hipError_t e = hipLaunchCooperativeKernel((const void*)hybrid_fwd, dim3(grid), dim3(512), args, LDS_BYTES, stream);
    if (e != hipSuccess) fprintf(stderr, "cooperative launch failed: %s (grid %d)\n", hipGetErrorString(e), grid);
#else
    for (int ph = 0; ph < NPHASE; ++ph) {
        a.ph_lo = ph; a.ph_hi = ph + 1;
        hipLaunchKernelGGL(hybrid_fwd, dim3(grid), dim3(512), LDS_BYTES, stream, a);
    }
#endif
}
```

```cpp
#include <hip/hip_runtime.h>
#include <hip/hip_cooperative_groups.h>
#include <cstdio>
#include <cstdint>
namespace cg = cooperative_groups;

#ifndef DUPM
#define DUPM 0
#endif
#ifndef SKIPM
#define SKIPM 0
#endif
#ifndef ONE_LAUNCH
#define ONE_LAUNCH 1
#endif

#define LAS __attribute__((address_space(3)))
#define DI __device__ __forceinline__
typedef unsigned short bf16_t;
typedef short bf16x8 __attribute__((ext_vector_type(8)));
typedef float f32x4 __attribute__((ext_vector_type(4)));
typedef unsigned u32x4 __attribute__((ext_vector_type(4)));
typedef unsigned u32x2 __attribute__((ext_vector_type(2)));

constexpr int S = 8192, DM = 2048, NL = 4, NPROJ = 13312, INCOLS = 13344, DMIX = 4096;
constexpr int ZOFF = 0, XOFF = 2048, BOFF = 4096, COFF = 4608, QOFF = 5120, KOFF = 7168, VOFF = 9216, GOFF = 11264;
constexpr int NCHUNK = 128, NH = 32, CONVD = 3072;
constexpr float EPS = 1e-6f;
constexpr int LDS_BYTES = 147456;
constexpr int NPHASE = 2 + 5 * NL;

constexpr size_t WS_WIN = 0;
constexpr size_t WS_WDT = WS_WIN + (size_t)NL * NPROJ * DM * 2;
constexpr size_t WS_WOUT = WS_WDT + (size_t)NL * 32 * DM * 2;
constexpr size_t WS_XB = WS_WOUT + (size_t)NL * DM * DMIX * 2;
constexpr size_t WS_XRES = WS_XB + (size_t)S * DM * 2;
constexpr size_t WS_PROJ = WS_XRES + (size_t)S * DM * 4;
constexpr size_t WS_DTRAW = WS_PROJ + (size_t)S * NPROJ * 2;
constexpr size_t WS_MIX = WS_DTRAW + (size_t)S * 32 * 4;
constexpr size_t WS_STATES = WS_MIX + (size_t)S * DMIX * 2;
constexpr size_t WS_CDEC = WS_STATES + (size_t)NCHUNK * NH * 64 * 128 * 2;
constexpr size_t WS_SSP = WS_CDEC + (size_t)NCHUNK * NH * 4;
constexpr size_t WS_XACT = WS_SSP + (size_t)8 * S * 4;
constexpr size_t WS_BAR = WS_XACT + (size_t)S * CONVD * 2;
constexpr size_t WS_END = WS_BAR + 16384;

DI unsigned pk2(float lo, float hi) { unsigned r; asm volatile("v_cvt_pk_bf16_f32 %0, %1, %2" : "=v"(r) : "v"(lo), "v"(hi)); return r; }
DI int opaque_tid() { int t = threadIdx.x; asm volatile("" : "+v"(t)); return t; }
DI float bf_lo(unsigned w) { return __uint_as_float(w << 16); }
DI float bf_hi(unsigned w) { return __uint_as_float(w & 0xffff0000u); }
DI float silu_f(float x) { return x * __builtin_amdgcn_rcpf(1.0f + __expf(-x)); }
DI f32x4 mfma16(bf16x8 a, bf16x8 b, f32x4 c) { return __builtin_amdgcn_mfma_f32_16x16x32_bf16(a, b, c, 0, 0, 0); }
typedef short s16x4 __attribute__((ext_vector_type(4)));
DI bf16x8 tr_frag(LAS unsigned char* base, int stride_el, int row0, int col0, int fr) {
    const int q = fr >> 2, p_ = fr & 3;
    LAS unsigned char* p0 = base + ((row0 + q) * stride_el + col0 + 4 * p_) * 2;
    const s16x4 lo = __builtin_amdgcn_ds_read_tr16_b64_v4i16((LAS s16x4*)p0);
    const s16x4 hi = __builtin_amdgcn_ds_read_tr16_b64_v4i16((LAS s16x4*)(p0 + 8 * stride_el));
    bf16x8 r; r[0] = lo[0]; r[1] = lo[1]; r[2] = lo[2]; r[3] = lo[3]; r[4] = hi[0]; r[5] = hi[1]; r[6] = hi[2]; r[7] = hi[3];
    return r;
}
DI float row_rstd(const float* ssp, int row) {
    float s = 0.f;
#pragma unroll
    for (int j = 0; j < 8; ++j) s += ssp[j * S + row];
    return rsqrtf(s * (1.0f / DM) + EPS);
}

namespace pg8 {
constexpr int BM = 256, BK = 64, HALF = 128, HTB = HALF * BK * 2, STAGE_BYTES = 8 * HTB, NXCD = 8, WGM = 8;
DI int lds_byte(int r, int c) { const int st = (r >> 4) * 2 + (c >> 5), rr = r & 15, cc = c & 31, ob = rr * 64 + cc * 2; return st * 1024 + (ob ^ (((ob >> 9) & 1) << 5)); }
DI void stage_rc(int b, int& R, int& C) { const int st = b / 1024, sb = b % 1024, swz = sb ^ (((sb >> 9) & 1) << 5); R = (st >> 1) * 16 + swz / 64; C = (st & 1) * 32 + (swz % 64) / 2; }
DI int perm32(int rho) { const int n = rho >> 4, i = rho & 15; return 8 * (i >> 2) + 4 * n + (i & 3); }
struct Unit { int pm, pn; };
struct Gemm { const bf16_t* A; const bf16_t* Bt; int M, N, K; };
struct StaticOrder {
    int nM, nN, nwg, G, c;
    DI void init(int M, int N, int G_, int c_) { nM = M / BM; nN = N / BM; nwg = nM * nN; G = G_; c = c_; }
    DI bool next(int i, Unit& u) const {
        const long L = (long)i * G + c; if (L >= nwg) return false;
        int wgid = (int)L; { const int q = nwg / NXCD, r = nwg % NXCD, xcd = wgid % NXCD, off = wgid / NXCD; wgid = (xcd < r ? xcd * (q + 1) : r * (q + 1) + (xcd - r) * q) + off; }
        const int nig = WGM * nN, gid = wgid / nig, fm = gid * WGM, gsz = (nM - fm) < WGM ? (nM - fm) : WGM;
        u.pm = fm + ((wgid % nig) % gsz); u.pn = (wgid % nig) / gsz; return true;
    }
};

template <class Epi>
DI void gemm_phase(LAS unsigned char* lds, const Gemm g, const StaticOrder& S_, const Epi& E) {
    const int tid = opaque_tid(), wid = __builtin_amdgcn_readfirstlane(tid >> 6), lane = tid & 63, wr = wid >> 2, wc = wid & 3, fr = lane & 15, fq = lane >> 4;
    const int K = g.K, nt = K / BK;
    unsigned voffA[2], voffB[2];
#pragma unroll
    for (int i = 0; i < 2; ++i) { int R, C; stage_rc(tid * 16 + i * 8192, R, C); const int Rb = Epi::PERM ? ((R & ~31) + perm32(R & 31)) : R;
        voffA[i] = (unsigned)(R * K + C) * 2u; voffB[i] = (unsigned)(Rb * K + C) * 2u; }
    const size_t kstep = (size_t)(BK * 2);
    const size_t hstep = (size_t)HALF * K * 2;
    const size_t tstep = 2 * hstep;
    const unsigned ldsw = (unsigned)wid * 1024u;
    const int aoff = lds_byte(wr * 64 + fr, fq * 8), boff = lds_byte(wc * 32 + fr, fq * 8);
#define PG8_SA(b, h) (((b) * 2 + (h)) * HTB)
#define PG8_SB(b, h) ((4 + (b) * 2 + (h)) * HTB)
#define PG8_STAGE(bufoff, gbase, voff) do { _Pragma("unroll") for (int _i = 0; _i < 2; ++_i) \
        __builtin_amdgcn_global_load_lds((const unsigned*)((const char*)(gbase) + (voff)[_i]), (LAS unsigned*)(lds + (bufoff) + ldsw + _i * 8192), 16, 0, 0); } while (0)
#define PG8_LDA(dst, b, h) do { _Pragma("unroll") for (int m = 0; m < 4; ++m) _Pragma("unroll") for (int k = 0; k < 2; ++k) dst[m][k] = *(const LAS bf16x8*)(lds + PG8_SA(b, h) + aoff + m * 2048 + k * 1024); } while (0)
#define PG8_LDB(dst, b, h) do { _Pragma("unroll") for (int n = 0; n < 2; ++n) _Pragma("unroll") for (int k = 0; k < 2; ++k) dst[n][k] = *(const LAS bf16x8*)(lds + PG8_SB(b, h) + boff + n * 2048 + k * 1024); } while (0)
#define PG8_MMA(ai, bj, At, Bt) do { __builtin_amdgcn_s_setprio(1); _Pragma("unroll") for (int m = 0; m < 4; ++m) _Pragma("unroll") for (int n = 0; n < 2; ++n) _Pragma("unroll") for (int k = 0; k < 2; ++k) \
        acc[ai][bj][m][n] = __builtin_amdgcn_mfma_f32_16x16x32_bf16(Bt[n][k], At[m][k], acc[ai][bj][m][n], 0, 0, 0); __builtin_amdgcn_s_setprio(0); } while (0)
#define PG8_WAIT_V(n) asm volatile("s_waitcnt vmcnt(" #n ")" ::: "memory")
#define PG8_WAIT_L(n) asm volatile("s_waitcnt lgkmcnt(" #n ")" ::: "memory")
#define PG8_BAR __builtin_amdgcn_s_barrier()
#define PG8_SCHED __builtin_amdgcn_sched_barrier(0)
    Unit cur, nxt; int ui = 0;
    if (!S_.next(0, cur)) return;
    f32x4 acc[2][2][4][2];
#pragma unroll
    for (int a = 0; a < 2; ++a)
#pragma unroll
        for (int b = 0; b < 2; ++b)
#pragma unroll
            for (int m = 0; m < 4; ++m)
#pragma unroll
                for (int n = 0; n < 2; ++n) acc[a][b][m][n] = (f32x4){0.f, 0.f, 0.f, 0.f};
    bf16x8 At[4][2], B0[2][2], B1[2][2];
    const char* cA = (const char*)g.A + (size_t)cur.pm * tstep; const char* cB = (const char*)g.Bt + (size_t)cur.pn * tstep;
    PG8_STAGE(PG8_SB(0, 0), cB, voffB); PG8_STAGE(PG8_SA(0, 0), cA, voffA); PG8_STAGE(PG8_SB(0, 1), cB + hstep, voffB); PG8_STAGE(PG8_SA(0, 1), cA + hstep, voffA);
    if (wr == 1) PG8_BAR;
    PG8_WAIT_V(4); PG8_BAR;
    PG8_STAGE(PG8_SB(1, 0), cB + kstep, voffB); PG8_STAGE(PG8_SA(1, 0), cA + kstep, voffA); PG8_STAGE(PG8_SB(1, 1), cB + hstep + kstep, voffB);
    PG8_WAIT_V(6); PG8_BAR;
    for (;;) {
        const bool has_next = S_.next(ui + 1, nxt);
        const char* nA = has_next ? (const char*)g.A + (size_t)nxt.pm * tstep : cA; const char* nB = has_next ? (const char*)g.Bt + (size_t)nxt.pn * tstep : cB;
        for (int t = 0; t < nt; t += 2) {
            const bool last = (t == nt - 2);
            const char* a1 = cA + (size_t)(t + 1) * kstep;
            const char* a2 = last ? nA : cA + (size_t)(t + 2) * kstep; const char* b2 = last ? nB : cB + (size_t)(t + 2) * kstep;
            const char* a3 = a2 + kstep; const char* b3 = b2 + kstep;
            PG8_LDB(B0, 0, 0); PG8_SCHED; PG8_LDA(At, 0, 0); PG8_STAGE(PG8_SA(1, 1), a1 + hstep, voffA);
            PG8_WAIT_L(8); PG8_BAR; PG8_WAIT_L(0); PG8_MMA(0, 0, At, B0); PG8_BAR; PG8_SCHED;
            PG8_LDB(B1, 0, 1); PG8_STAGE(PG8_SB(0, 0), b2, voffB);
            PG8_BAR; PG8_WAIT_L(0); PG8_MMA(0, 1, At, B1); PG8_BAR;
            PG8_LDA(At, 0, 1); PG8_STAGE(PG8_SA(0, 0), a2, voffA);
            PG8_BAR; PG8_WAIT_L(0); PG8_MMA(1, 0, At, B0); PG8_BAR; PG8_SCHED;
            PG8_STAGE(PG8_SB(0, 1), b2 + hstep, voffB);
            PG8_WAIT_V(6); PG8_BAR; PG8_MMA(1, 1, At, B1); PG8_BAR;
            PG8_LDB(B0, 1, 0); PG8_SCHED; PG8_LDA(At, 1, 0); PG8_STAGE(PG8_SA(0, 1), a2 + hstep, voffA);
            PG8_WAIT_L(8); PG8_BAR; PG8_WAIT_L(0); PG8_MMA(0, 0, At, B0); PG8_BAR; PG8_SCHED;
            PG8_LDB(B1, 1, 1); PG8_STAGE(PG8_SB(1, 0), b3, voffB);
            PG8_BAR; PG8_WAIT_L(0); PG8_MMA(0, 1, At, B1); PG8_BAR;
            PG8_LDA(At, 1, 1); PG8_STAGE(PG8_SA(1, 0), a3, voffA);
            PG8_BAR; PG8_WAIT_L(0); PG8_MMA(1, 0, At, B0); PG8_BAR; PG8_SCHED;
            PG8_STAGE(PG8_SB(1, 1), b3 + hstep, voffB);
            PG8_WAIT_V(6); PG8_BAR; PG8_MMA(1, 1, At, B1); PG8_BAR;
        }
        if constexpr (!Epi::AFTER_DRAIN) { E(acc, cur, wr, wc, fr, fq); }
        if (!has_next) break;
#pragma unroll
        for (int a = 0; a < 2; ++a)
#pragma unroll
            for (int b = 0; b < 2; ++b)
#pragma unroll
                for (int m = 0; m < 4; ++m)
#pragma unroll
                    for (int n = 0; n < 2; ++n) acc[a][b][m][n] = (f32x4){0.f, 0.f, 0.f, 0.f};
        cur = nxt; cA = nA; cB = nB; ++ui;
    }
    PG8_WAIT_V(0);
    if (wr == 0) PG8_BAR;
    PG8_BAR;
    if constexpr (Epi::AFTER_DRAIN) { E.fused(acc, cur, wr, wc, fr, fq, lds, wid, lane); }
#undef PG8_SA
#undef PG8_SB
#undef PG8_STAGE
#undef PG8_LDA
#undef PG8_LDB
#undef PG8_MMA
#undef PG8_WAIT_V
#undef PG8_WAIT_L
#undef PG8_BAR
#undef PG8_SCHED
}

struct EpiInProj {
    static constexpr bool PERM = true, AFTER_DRAIN = false;
    bf16_t* O; const float* ssp; const LAS float* rs_lds; int pm0;
    DI void operator()(const f32x4 (&acc)[2][2][4][2], const Unit& u, int wr, int wc, int fr, int fq) const {
        const int row0 = u.pm * BM + wr * 64 + fr; const int col0 = u.pn * BM + wc * 32 + 8 * fq;
        const bool lds_ok = (u.pm == pm0);
#pragma unroll
        for (int ai = 0; ai < 2; ++ai)
#pragma unroll
            for (int m = 0; m < 4; ++m) {
                const int row = row0 + ai * HALF + m * 16;
                const float rs = lds_ok ? rs_lds[wr * 64 + fr + ai * HALF + m * 16] : row_rstd(ssp, row);
                bf16_t* rowp = O + (size_t)row * NPROJ + col0;
#pragma unroll
                for (int bj = 0; bj < 2; ++bj) {
                    const f32x4 v0 = acc[ai][bj][m][0] * rs, v1 = acc[ai][bj][m][1] * rs;
                    u32x4 w; w.x = pk2(v0[0], v0[1]); w.y = pk2(v0[2], v0[3]); w.z = pk2(v1[0], v1[1]); w.w = pk2(v1[2], v1[3]);
                    *(u32x4*)(rowp + bj * HALF) = w;
                }
            }
    }
};
struct EpiOutProj {
    static constexpr bool PERM = true, AFTER_DRAIN = true;
    bf16_t* xb; float* ssp;
    DI void operator()(const f32x4 (&)[2][2][4][2], const Unit&, int, int, int, int) const {}
    DI void fused(const f32x4 (&acc)[2][2][4][2], const Unit& u, int wr, int wc, int fr, int fq, LAS unsigned char* lds, int wid, int lane) const {
        LAS float* red = (LAS float*)lds;
        const int row0 = u.pm * BM + wr * 64 + fr; const int col0 = u.pn * BM + wc * 32 + 8 * fq;
        u32x4 xo[2][4][2];
#pragma unroll
        for (int ai = 0; ai < 2; ++ai)
#pragma unroll
            for (int m = 0; m < 4; ++m)
#pragma unroll
                for (int bj = 0; bj < 2; ++bj) xo[ai][m][bj] = *(const u32x4*)(xb + (size_t)(row0 + ai * HALF + m * 16) * DM + col0 + bj * HALF);
#pragma unroll
        for (int ai = 0; ai < 2; ++ai)
#pragma unroll
            for (int m = 0; m < 4; ++m) {
                const int row = row0 + ai * HALF + m * 16; float ss = 0.f;
#pragma unroll
                for (int bj = 0; bj < 2; ++bj) {
                    const u32x4 o = xo[ai][m][bj];
                    const f32x4 a0 = acc[ai][bj][m][0], a1 = acc[ai][bj][m][1];
                    u32x4 pb;
                    pb.x = pk2(bf_lo(o.x) + a0[0], bf_hi(o.x) + a0[1]); pb.y = pk2(bf_lo(o.y) + a0[2], bf_hi(o.y) + a0[3]);
                    pb.z = pk2(bf_lo(o.z) + a1[0], bf_hi(o.z) + a1[1]); pb.w = pk2(bf_lo(o.w) + a1[2], bf_hi(o.w) + a1[3]);
                    *(u32x4*)(xb + (size_t)row * DM + col0 + bj * HALF) = pb;
                    const float y0 = bf_lo(pb.x), y1 = bf_hi(pb.x), y2 = bf_lo(pb.y), y3 = bf_hi(pb.y), y4 = bf_lo(pb.z), y5 = bf_hi(pb.z), y6 = bf_lo(pb.w), y7 = bf_hi(pb.w);
                    ss += ((y0 * y0 + y1 * y1) + (y2 * y2 + y3 * y3)) + ((y4 * y4 + y5 * y5) + (y6 * y6 + y7 * y7));
                }
                ss += __shfl_xor(ss, 16); ss += __shfl_xor(ss, 32);
                if (fq == 0) red[wc * 256 + wr * 64 + fr + ai * HALF + m * 16] = ss;
            }
        __syncthreads();
        const int tid = opaque_tid();
        if (tid < 256) ssp[(size_t)u.pn * S + u.pm * BM + tid] = (red[tid] + red[256 + tid]) + (red[512 + tid] + red[768 + tid]);
        __syncthreads();
    }
};
}

#define XB_TMO      128
#define XB_XCNT(j)  (256  + 64 * (j))
#define XB_XSUB(j)  (1280 + 64 * (j))
#define XB_XGEN(j)  (2304 + 64 * (j))
#define XB_TOP      3328
#define XB_TOPGEN   3392
#define XCD_BAR_WORDS 3456
#define XB_SPIN_CAP (1u << 20)
DI unsigned xb_ld(unsigned* p)              { return __hip_atomic_load(p, __ATOMIC_RELAXED, __HIP_MEMORY_SCOPE_AGENT); }
DI unsigned xb_add(unsigned* p, unsigned v) { return __hip_atomic_fetch_add(p, v, __ATOMIC_RELAXED, __HIP_MEMORY_SCOPE_AGENT); }
DI unsigned xb_xcc_id() { return (unsigned)__builtin_amdgcn_s_getreg((3 << 11) | 20) & 0xFu; }
#define XB_SPIN(cond, bar) do { unsigned _sp = 0; while (cond) { __builtin_amdgcn_s_sleep(1); \
    if ((++_sp & 255u) == 0u) { if (xb_ld(&(bar)[XB_TMO])) break; if (_sp > XB_SPIN_CAP) { atomicAdd(&(bar)[XB_TMO], 1u); break; } } } } while (0)
struct XcdBarrier { unsigned* bar; unsigned x; volatile LAS unsigned* st; };
DI XcdBarrier xcd_barrier_post(unsigned* bar, volatile LAS unsigned* st) {
    XcdBarrier b; b.bar = bar; b.x = xb_xcc_id(); b.st = st;
    if (threadIdx.x == 0) st[2] = xb_add(&bar[XB_XCNT(b.x)], 1u);
    return b;
}
DI void xcd_barrier_complete(unsigned* bar, unsigned x, unsigned& nloc, unsigned& nx) {
    const unsigned G = gridDim.x * gridDim.y * gridDim.z;
    unsigned sum, cnt, mine, sp = 0u;
    for (;;) {
        sum = 0u; cnt = 0u; mine = 0u;
#pragma unroll
        for (unsigned j = 0; j < 16; ++j) { const unsigned c = xb_ld(&bar[XB_XCNT(j)]); sum += c; cnt += (c > 0u) ? 1u : 0u; mine = (j == x) ? c : mine; }
        if (sum == G) break;
        __builtin_amdgcn_s_sleep(1);
        if ((++sp & 255u) == 0u) { if (xb_ld(&bar[XB_TMO])) break; if (sp > XB_SPIN_CAP) { atomicAdd(&bar[XB_TMO], 1u); break; } }
    }
    nloc = mine > 0u ? mine : 1u; nx = cnt > 0u ? cnt : 1u;
}
DI void xcd_barrier(const XcdBarrier& b) {
    asm volatile("s_waitcnt vmcnt(0)" ::: "memory");
    __syncthreads();
    if (threadIdx.x == 0) {
        unsigned* bar = b.bar;
        __builtin_amdgcn_s_waitcnt(0);
        unsigned nloc = b.st[0], nx = b.st[1];
        if (nloc == 0u) { xcd_barrier_complete(bar, b.x, nloc, nx); b.st[0] = nloc; b.st[1] = nx; }
        const unsigned old = xb_add(&bar[XB_XSUB(b.x)], 1u);
        const unsigned gen = old / nloc;
        if (old + 1u == (gen + 1u) * nloc) {
            __builtin_amdgcn_fence(__ATOMIC_RELEASE, "agent");
            asm volatile("s_waitcnt vmcnt(0)" ::: "memory");
            const unsigned og = xb_add(&bar[XB_TOP], 1u);
            const unsigned tg = og / nx;
            if (og + 1u == (tg + 1u) * nx) xb_add(&bar[XB_TOPGEN], 1u);
            else XB_SPIN(xb_ld(&bar[XB_TOPGEN]) == tg, bar);
            __builtin_amdgcn_fence(__ATOMIC_ACQUIRE, "agent");
            xb_add(&bar[XB_XGEN(b.x)], 1u);
            asm volatile("s_waitcnt vmcnt(0)" ::: "memory");
        } else {
            XB_SPIN(xb_ld(&bar[XB_XGEN(b.x)]) == gen, bar);
            __builtin_amdgcn_fence(__ATOMIC_ACQUIRE, "agent");
            asm volatile("s_waitcnt vmcnt(0)" ::: "memory");
        }
    }
    __syncthreads();
}

struct Args {
    const float* x; const float* norm_w; const float* w_in; const float* conv_w; const float* conv_b;
    const float* dt_bias; const float* a_log; const float* d_skip; const float* ssd_norm_w; const float* w_out; const float* final_norm_w;
    float* out; unsigned char* ws; int ph_lo, ph_hi;
};

DI void conv_load(const bf16_t* proj, int t0, int l0, int cc, u32x4 (&raw)[7]) {
#pragma unroll
    for (int i = 0; i < 7; ++i) {
        const int t = t0 + l0 - 3 + i;
        if (t >= 0) raw[i] = *(const u32x4*)(proj + (size_t)t * NPROJ + XOFF + cc);
        else raw[i] = (u32x4){0u, 0u, 0u, 0u};
    }
}
DI void conv_compute(const u32x4 (&raw)[7], const float* cw, const float* cb, int cc, float (&out)[4][8]) {
    float w[4][8], b[8];
#pragma unroll
    for (int j = 0; j < 4; ++j) {
        const f32x4 w0 = *(const f32x4*)(cw + j * CONVD + cc), w1 = *(const f32x4*)(cw + j * CONVD + cc + 4);
        w[j][0] = w0[0]; w[j][1] = w0[1]; w[j][2] = w0[2]; w[j][3] = w0[3]; w[j][4] = w1[0]; w[j][5] = w1[1]; w[j][6] = w1[2]; w[j][7] = w1[3];
    }
    { const f32x4 b0 = *(const f32x4*)(cb + cc), b1 = *(const f32x4*)(cb + cc + 4);
      b[0] = b0[0]; b[1] = b0[1]; b[2] = b0[2]; b[3] = b0[3]; b[4] = b1[0]; b[5] = b1[1]; b[6] = b1[2]; b[7] = b1[3]; }
#pragma unroll
    for (int i = 0; i < 4; ++i)
#pragma unroll
        for (int e = 0; e < 8; ++e) {
            float a = b[e];
#pragma unroll
            for (int j = 0; j < 4; ++j) {
                const unsigned wd = raw[i + j][e >> 1];
                a += w[j][e] * ((e & 1) ? bf_hi(wd) : bf_lo(wd));
            }
            out[i][e] = silu_f(a);
        }
}

DI void head_dt(const float* dtraw, const float* dt_bias, const float* a_log, int t0, int h, int lane, float& dtv, float& acum) {
    const float xr = dtraw[(size_t)(t0 + lane) * 32 + h] + dt_bias[h];
    dtv = (xr > 20.f) ? xr : log1pf(expf(xr));
    const float A = -expf(a_log[h]);
    float v = dtv * A;
#pragma unroll
    for (int o = 1; o < 64; o <<= 1) { const float t = __shfl_up(v, o); if (lane >= o) v += t; }
    acum = v;
}

DI void transpose_item(const float* W, int Nsrc, int k0, int n0, const float* nw, bf16_t* dst, int Kdst, LAS float* scr, int lane) {
    f32x4 v[16]; float sc[16];
#pragma unroll
    for (int i = 0; i < 16; ++i) {
        const int kk = 8 * i + (lane >> 3);
        v[i] = __builtin_nontemporal_load((const f32x4*)(W + (size_t)(k0 + kk) * Nsrc + n0 + 4 * (lane & 7)));
        sc[i] = nw ? nw[k0 + kk] : 1.0f;
    }
#pragma unroll
    for (int i = 0; i < 16; ++i) {
        const int kk = 8 * i + (lane >> 3);
        LAS float* p = scr + kk * 33 + 4 * (lane & 7);
        p[0] = v[i][0] * sc[i]; p[1] = v[i][1] * sc[i]; p[2] = v[i][2] * sc[i]; p[3] = v[i][3] * sc[i];
    }
    asm volatile("s_waitcnt lgkmcnt(0)" ::: "memory");
    const int c = lane & 15;
#pragma unroll
    for (int j = 0; j < 8; ++j) {
        const int n = (lane >> 4) + 4 * j; const LAS float* s = scr + (8 * c) * 33 + n;
        u32x4 o; o.x = pk2(s[0 * 33], s[1 * 33]); o.y = pk2(s[2 * 33], s[3 * 33]); o.z = pk2(s[4 * 33], s[5 * 33]); o.w = pk2(s[6 * 33], s[7 * 33]);
        *(u32x4*)(dst + (size_t)n * Kdst + k0 + 8 * c) = o;
    }
    asm volatile("s_waitcnt lgkmcnt(0)" ::: "memory");
}

constexpr int CV_IN_ITEMS = 16 * 417, CV_OUT_ITEMS = 32 * 64, CV_PER_L = CV_IN_ITEMS + CV_OUT_ITEMS;
#ifndef CV_SLOT_N
#define CV_SLOT_N 8720
#endif
constexpr int CV_SLOT = CV_SLOT_N;
DI void convert_item(const Args& a, int l, int r, LAS float* scr, int lane) {
    bf16_t* win = (bf16_t*)(a.ws + WS_WIN); bf16_t* wdt = (bf16_t*)(a.ws + WS_WDT); bf16_t* wout = (bf16_t*)(a.ws + WS_WOUT);
    if (r < CV_IN_ITEMS) {
        const int nb = r % 417, kb = r / 417; const int n0 = nb * 32;
        bf16_t* dst;
        if (nb < 160) dst = win + ((size_t)l * NPROJ + n0) * DM;
        else if (nb == 160) dst = wdt + (size_t)l * 32 * DM;
        else dst = win + ((size_t)l * NPROJ + n0 - 32) * DM;
        transpose_item(a.w_in + (size_t)l * DM * INCOLS, INCOLS, kb * 128, n0, a.norm_w + l * DM, dst, DM, scr, lane);
    } else {
        r -= CV_IN_ITEMS; const int nb = r % 64, kb = r / 64;
        transpose_item(a.w_out + (size_t)l * DMIX * DM, DM, kb * 128, nb * 32, nullptr, wout + ((size_t)l * DM + nb * 32) * DMIX, DMIX, scr, lane);
    }
}

DI void phase_prologue(const Args& a, LAS unsigned char* lds) {
    const int tid = opaque_tid(), lane = tid & 63, wave = tid >> 6;
    const int gw = blockIdx.x * 8 + wave, NGW = gridDim.x * 8;
    LAS float* scr = (LAS float*)(lds + wave * 16896);
    constexpr int PRO_ITEMS = CV_PER_L + (NL - 1) * (CV_PER_L - CV_SLOT);
    for (int it = gw; it < PRO_ITEMS; it += NGW) {
        if (it < CV_PER_L) convert_item(a, 0, it, scr, lane);
        else { const int j = it - CV_PER_L; convert_item(a, 1 + j / (CV_PER_L - CV_SLOT), j % (CV_PER_L - CV_SLOT), scr, lane); }
    }
    bf16_t* xb = (bf16_t*)(a.ws + WS_XB); float* ssp = (float*)(a.ws + WS_SSP);
    for (int row = gw; row < S; row += NGW) {
        const f32x4* xr = (const f32x4*)(a.x + (size_t)row * DM) + lane;
        float ss = 0.f;
#pragma unroll
        for (int j = 0; j < 8; ++j) {
            const f32x4 v = xr[64 * j];
            ss += (v[0] * v[0] + v[1] * v[1]) + (v[2] * v[2] + v[3] * v[3]);
            u32x2 pb; pb.x = pk2(v[0], v[1]); pb.y = pk2(v[2], v[3]);
            *(u32x2*)(xb + (size_t)row * DM + 256 * j + 4 * lane) = pb;
        }
#pragma unroll
        for (int o = 1; o < 64; o <<= 1) ss += __shfl_xor(ss, o);
        if (lane < 8) ssp[lane * S + row] = (lane == 0) ? ss : 0.f;
    }
}

DI void dt_gemm(const Args& a, int layer, int blk, int nblk, LAS unsigned char* lds) {
    const int tid = opaque_tid(), lane = tid & 63, wave = tid >> 6, fr = lane & 15, q4 = lane >> 4;
    const bf16_t* xb = (const bf16_t*)(a.ws + WS_XB); const bf16_t* wdt = (const bf16_t*)(a.ws + WS_WDT) + (size_t)layer * 32 * DM;
    const float* ssp = (const float*)(a.ws + WS_SSP); float* dtraw = (float*)(a.ws + WS_DTRAW);
    LAS float* P = (LAS float*)lds;
    for (int tg = blk; tg < S / 64; tg += nblk) {
        const int row0 = tg * 64, kw = wave * 256;
        bf16x8 b0[8], b1[8];
#pragma unroll
        for (int ks = 0; ks < 8; ++ks) {
            b0[ks] = *(const bf16x8*)(wdt + (size_t)fr * DM + kw + ks * 32 + q4 * 8);
            b1[ks] = *(const bf16x8*)(wdt + (size_t)(16 + fr) * DM + kw + ks * 32 + q4 * 8);
        }
#pragma unroll
        for (int t = 0; t < 4; ++t) {
            bf16x8 av[8];
#pragma unroll
            for (int ks = 0; ks < 8; ++ks) av[ks] = *(const bf16x8*)(xb + (size_t)(row0 + 16 * t + fr) * DM + kw + ks * 32 + q4 * 8);
            f32x4 acc0 = {0.f, 0.f, 0.f, 0.f}, acc1 = {0.f, 0.f, 0.f, 0.f};
#pragma unroll
            for (int ks = 0; ks < 8; ++ks) { acc0 = mfma16(av[ks], b0[ks], acc0); acc1 = mfma16(av[ks], b1[ks], acc1); }
#pragma unroll
            for (int r = 0; r < 4; ++r) { P[(((wave * 4 + t) * 2 + 0) * 4 + r) * 64 + lane] = acc0[r]; P[(((wave * 4 + t) * 2 + 1) * 4 + r) * 64 + lane] = acc1[r]; }
        }
        __syncthreads();
#pragma unroll
        for (int i = 0; i < 4; ++i) {
            const int o = tid + 512 * i;
            const int ln = o & 63, r = (o >> 6) & 3, j = (o >> 8) & 1, t = o >> 9;
            float sum = 0.f;
#pragma unroll
            for (int w = 0; w < 8; ++w) sum += P[w * 2048 + o];
            const int row = row0 + 16 * t + 4 * (ln >> 4) + r;
            dtraw[(size_t)row * 32 + 16 * j + (ln & 15)] = sum * row_rstd(ssp, row);
        }
        __syncthreads();
    }
}

constexpr int TS = 136, XS_STR = 520;
DI void ssd_states_unit(const Args& a, int layer, int c, int g, LAS unsigned char* lds) {
    const int tid = opaque_tid(), lane = tid & 63, wave = tid >> 6, fr = lane & 15, q4 = lane >> 4;
    const int t0 = c * 64, h = g * 8 + wave;
    const bf16_t* proj = (const bf16_t*)(a.ws + WS_PROJ);
    bf16_t* xact = (bf16_t*)(a.ws + WS_XACT);
    LAS unsigned char* BS = lds;
    LAS unsigned char* XS = lds + 64 * TS * 2;
    LAS float* WL = (LAS float*)(lds + 64 * TS * 2 + 64 * XS_STR * 2);
    {
        float dtv, ac;
        head_dt((const float*)(a.ws + WS_DTRAW), a.dt_bias + layer * NH, a.a_log + layer * NH, t0, h, lane, dtv, ac);
        const float alast = __shfl(ac, 63);
        WL[wave * 64 + lane] = __expf(alast - ac) * dtv;
        if (lane == 0) ((float*)(a.ws + WS_CDEC))[c * NH + h] = __expf(alast);
    }
    __syncthreads();
    const float* cw = a.conv_w + (size_t)layer * 4 * CONVD; const float* cb = a.conv_b + (size_t)layer * CONVD;
    u32x4 raw3[3][7];
#pragma unroll
    for (int k = 0; k < 3; ++k) {
        const int it = tid + 512 * k, cgi = it % 96, l0 = (it / 96) * 4;
        const int cc = (cgi < 64) ? g * 512 + cgi * 8 : (cgi < 80) ? 2048 + g * 128 + (cgi - 64) * 8 : 2560 + g * 128 + (cgi - 80) * 8;
        conv_load(proj, t0, l0, cc, raw3[k]);
    }
#pragma unroll
    for (int k = 0; k < 3; ++k) {
        const int it = tid + 512 * k;
        const int cgi = it % 96, l0 = (it / 96) * 4;
        const int cc = (cgi < 64) ? g * 512 + cgi * 8 : (cgi < 80) ? 2048 + g * 128 + (cgi - 64) * 8 : 2560 + g * 128 + (cgi - 80) * 8;
        float o[4][8];
        conv_compute(raw3[k], cw, cb, cc, o);
#pragma unroll
        for (int i = 0; i < 4; ++i) {
            u32x4 v; v.x = pk2(o[i][0], o[i][1]); v.y = pk2(o[i][2], o[i][3]); v.z = pk2(o[i][4], o[i][5]); v.w = pk2(o[i][6], o[i][7]);
            *(u32x4*)(xact + (size_t)(t0 + l0 + i) * CONVD + cc) = v;
            if (cgi >= 64 && cgi < 80) *(LAS u32x4*)(BS + ((l0 + i) * TS + (cgi - 64) * 8) * 2) = v;
        }
        if (cgi < 64) {
            const int hd = cgi >> 3;
#pragma unroll
            for (int i = 0; i < 4; ++i) {
                const float w = WL[hd * 64 + l0 + i];
                u32x4 v; v.x = pk2(o[i][0] * w, o[i][1] * w); v.y = pk2(o[i][2] * w, o[i][3] * w); v.z = pk2(o[i][4] * w, o[i][5] * w); v.w = pk2(o[i][6] * w, o[i][7] * w);
                *(LAS u32x4*)(XS + ((l0 + i) * XS_STR + cgi * 8) * 2) = v;
            }
        }
    }
    __syncthreads();
    f32x4 acc[8][4];
#pragma unroll
    for (int nb = 0; nb < 8; ++nb)
#pragma unroll
        for (int pb = 0; pb < 4; ++pb) acc[nb][pb] = (f32x4){0.f, 0.f, 0.f, 0.f};
#pragma unroll
    for (int ks = 0; ks < 2; ++ks) {
        bf16x8 xf[4];
#pragma unroll
        for (int pb = 0; pb < 4; ++pb) xf[pb] = tr_frag(XS, XS_STR, ks * 32 + q4 * 8, wave * 64 + pb * 16, fr);
#pragma unroll
        for (int nb = 0; nb < 8; ++nb) {
            const bf16x8 bfr = tr_frag(BS, TS, ks * 32 + q4 * 8, nb * 16, fr);
#pragma unroll
            for (int pb = 0; pb < 4; ++pb) acc[nb][pb] = mfma16(bfr, xf[pb], acc[nb][pb]);
        }
    }
    bf16_t* st = (bf16_t*)(a.ws + WS_STATES) + ((size_t)(c * NH + h) * 64) * 128;
#pragma unroll
    for (int nb = 0; nb < 8; ++nb)
#pragma unroll
        for (int pb = 0; pb < 4; ++pb) {
            u32x2 v; v.x = pk2(acc[nb][pb][0], acc[nb][pb][1]); v.y = pk2(acc[nb][pb][2], acc[nb][pb][3]);
            *(u32x2*)(st + (size_t)(pb * 16 + fr) * 128 + nb * 16 + 4 * q4) = v;
        }
    __syncthreads();
}

DI void phase_scan(const Args& a, unsigned char* states_base) {
    const int gt = blockIdx.x * 512 + opaque_tid(), NT = gridDim.x * 512;
    unsigned* st = (unsigned*)states_base; const float* cdec = (const float*)(a.ws + WS_CDEC);
    constexpr int PAIRS = NH * 64 * 128 / 2;
    for (int e = gt; e < PAIRS; e += NT) {
        const int h = e >> 12;
        float r0 = 0.f, r1 = 0.f;
        for (int c0 = 0; c0 < NCHUNK; c0 += 8) {
            unsigned v[8]; float d[8];
#pragma unroll
            for (int j = 0; j < 8; ++j) { v[j] = st[(size_t)(c0 + j) * PAIRS + e]; d[j] = cdec[(c0 + j) * NH + h]; }
#pragma unroll
            for (int j = 0; j < 8; ++j) {
                st[(size_t)(c0 + j) * PAIRS + e] = pk2(r0, r1);
                r0 = r0 * d[j] + bf_lo(v[j]); r1 = r1 * d[j] + bf_hi(v[j]);
            }
        }
    }
}

DI void ssd_out_unit(const Args& a, int layer, int c, int g, LAS unsigned char* lds) {
    const int tid = opaque_tid(), lane = tid & 63, wave = tid >> 6, fr = lane & 15, q4 = lane >> 4;
    const int t0 = c * 64, h = g * 8 + wave;
    const bf16_t* proj = (const bf16_t*)(a.ws + WS_PROJ);
    const bf16_t* xact = (const bf16_t*)(a.ws + WS_XACT);
    LAS unsigned char* CS = lds;
    LAS unsigned char* BS = lds + 64 * TS * 2;
    LAS unsigned char* XS = lds + 2 * 64 * TS * 2;
    LAS float* GS = (LAS float*)(lds + 2 * 64 * TS * 2 + 64 * XS_STR * 2);
    LAS float* DTS = GS + 64 * 68;
    LAS float* ACS = DTS + 512;
    LAS float* SSQ = ACS + 512;
    const bf16_t* prev = (const bf16_t*)(a.ws + WS_STATES) + ((size_t)(c * NH + h) * 64) * 128;
    bf16x8 pf[4][4];
#pragma unroll
    for (int ks = 0; ks < 4; ++ks)
#pragma unroll
        for (int pb = 0; pb < 4; ++pb) pf[ks][pb] = *(const bf16x8*)(prev + (size_t)(pb * 16 + fr) * 128 + ks * 32 + q4 * 8);
    u32x2 zr[4][4];
#pragma unroll
    for (int lb = 0; lb < 4; ++lb)
#pragma unroll
        for (int pb = 0; pb < 4; ++pb) zr[lb][pb] = *(const u32x2*)(proj + (size_t)(t0 + lb * 16 + fr) * NPROJ + ZOFF + h * 64 + pb * 16 + 4 * q4);
    {
        float dtv, ac;
        head_dt((const float*)(a.ws + WS_DTRAW), a.dt_bias + layer * NH, a.a_log + layer * NH, t0, h, lane, dtv, ac);
        DTS[wave * 64 + lane] = dtv; ACS[wave * 64 + lane] = ac;
    }
    {
        u32x4 xv[8], bv[2], cv[2];
#pragma unroll
        for (int i = 0; i < 8; ++i) { const int piece = tid + 512 * i, row = piece >> 6, ch = piece & 63; xv[i] = *(const u32x4*)(xact + (size_t)(t0 + row) * CONVD + g * 512 + ch * 8); }
#pragma unroll
        for (int i = 0; i < 2; ++i) { const int piece = tid + 512 * i, row = piece >> 4, ch = piece & 15;
            bv[i] = *(const u32x4*)(xact + (size_t)(t0 + row) * CONVD + 2048 + g * 128 + ch * 8); cv[i] = *(const u32x4*)(xact + (size_t)(t0 + row) * CONVD + 2560 + g * 128 + ch * 8); }
#pragma unroll
        for (int i = 0; i < 8; ++i) { const int piece = tid + 512 * i, row = piece >> 6, ch = piece & 63; *(LAS u32x4*)(XS + (row * XS_STR + ch * 8) * 2) = xv[i]; }
#pragma unroll
        for (int i = 0; i < 2; ++i) { const int piece = tid + 512 * i, row = piece >> 4, ch = piece & 15;
            *(LAS u32x4*)(BS + (row * TS + ch * 8) * 2) = bv[i]; *(LAS u32x4*)(CS + (row * TS + ch * 8) * 2) = cv[i]; }
    }
    __syncthreads();
    {
        const int lb = wave >> 1;
#pragma unroll
        for (int sj = 0; sj < 2; ++sj) {
            const int sb = 2 * (wave & 1) + sj;
            f32x4 gacc = {0.f, 0.f, 0.f, 0.f};
#pragma unroll
            for (int ks = 0; ks < 4; ++ks) {
                const bf16x8 cf = *(const LAS bf16x8*)(CS + ((lb * 16 + fr) * TS + ks * 32 + q4 * 8) * 2);
                const bf16x8 bfr = *(const LAS bf16x8*)(BS + ((sb * 16 + fr) * TS + ks * 32 + q4 * 8) * 2);
                gacc = mfma16(cf, bfr, gacc);
            }
#pragma unroll
            for (int r = 0; r < 4; ++r) GS[(lb * 16 + 4 * q4 + r) * 68 + sb * 16 + fr] = gacc[r];
        }
    }
    __syncthreads();
    f32x4 acc[4][4];
#pragma unroll
    for (int pb = 0; pb < 4; ++pb)
#pragma unroll
        for (int lb = 0; lb < 4; ++lb) acc[pb][lb] = (f32x4){0.f, 0.f, 0.f, 0.f};
#pragma unroll
    for (int ks = 0; ks < 4; ++ks) {
        bf16x8 cf[4];
#pragma unroll
        for (int lb = 0; lb < 4; ++lb) cf[lb] = *(const LAS bf16x8*)(CS + ((lb * 16 + fr) * TS + ks * 32 + q4 * 8) * 2);
#pragma unroll
        for (int pb = 0; pb < 4; ++pb)
#pragma unroll
            for (int lb = 0; lb < 4; ++lb) acc[pb][lb] = mfma16(pf[ks][pb], cf[lb], acc[pb][lb]);
    }
    float acl[4];
#pragma unroll
    for (int lb = 0; lb < 4; ++lb) {
        acl[lb] = ACS[wave * 64 + lb * 16 + fr];
        const float el = __expf(acl[lb]);
#pragma unroll
        for (int pb = 0; pb < 4; ++pb) acc[pb][lb] *= el;
    }
    const float Dh = a.d_skip[layer * NH + h];
#pragma unroll
    for (int ks2 = 0; ks2 < 2; ++ks2) {
        float as8[8], ds8[8];
        {
            const f32x4 a0 = *(const LAS f32x4*)(ACS + wave * 64 + ks2 * 32 + q4 * 8), a1 = *(const LAS f32x4*)(ACS + wave * 64 + ks2 * 32 + q4 * 8 + 4);
            const f32x4 d0 = *(const LAS f32x4*)(DTS + wave * 64 + ks2 * 32 + q4 * 8), d1 = *(const LAS f32x4*)(DTS + wave * 64 + ks2 * 32 + q4 * 8 + 4);
#pragma unroll
            for (int j = 0; j < 4; ++j) { as8[j] = a0[j]; as8[4 + j] = a1[j]; ds8[j] = d0[j]; ds8[4 + j] = d1[j]; }
        }
        bf16x8 xf[4];
#pragma unroll
        for (int pb = 0; pb < 4; ++pb) xf[pb] = tr_frag(XS, XS_STR, ks2 * 32 + q4 * 8, wave * 64 + pb * 16, fr);
#pragma unroll
        for (int lb = 0; lb < 4; ++lb) {
            if (ks2 * 32 > lb * 16 + 15) continue;
            const int l = lb * 16 + fr;
            const f32x4 g0 = *(const LAS f32x4*)(GS + l * 68 + ks2 * 32 + q4 * 8), g1 = *(const LAS f32x4*)(GS + l * 68 + ks2 * 32 + q4 * 8 + 4);
            float mv[8];
#pragma unroll
            for (int j = 0; j < 8; ++j) {
                const int s_ = ks2 * 32 + q4 * 8 + j;
                const float gv = (j < 4) ? g0[j & 3] : g1[j & 3];
                float v = (s_ <= l) ? gv * __expf(acl[lb] - as8[j]) * ds8[j] : 0.f;
                if (s_ == l) v += Dh;
                mv[j] = v;
            }
            u32x4 mp; mp.x = pk2(mv[0], mv[1]); mp.y = pk2(mv[2], mv[3]); mp.z = pk2(mv[4], mv[5]); mp.w = pk2(mv[6], mv[7]);
            const bf16x8 mf = __builtin_bit_cast(bf16x8, mp);
#pragma unroll
            for (int pb = 0; pb < 4; ++pb) acc[pb][lb] = mfma16(xf[pb], mf, acc[pb][lb]);
        }
    }
#pragma unroll
    for (int lb = 0; lb < 4; ++lb) {
        const int l = lb * 16 + fr; float ss = 0.f;
#pragma unroll
        for (int pb = 0; pb < 4; ++pb) {
            const u32x2 z2 = zr[lb][pb];
            f32x4 y = acc[pb][lb];
            y[0] *= silu_f(bf_lo(z2.x)); y[1] *= silu_f(bf_hi(z2.x)); y[2] *= silu_f(bf_lo(z2.y)); y[3] *= silu_f(bf_hi(z2.y));
            acc[pb][lb] = y;
            ss += (y[0] * y[0] + y[1] * y[1]) + (y[2] * y[2] + y[3] * y[3]);
        }
        ss += __shfl_xor(ss, 16); ss += __shfl_xor(ss, 32);
        if (q4 == 0) SSQ[wave * 64 + l] = ss;
    }
    __syncthreads();
    bf16_t* mix = (bf16_t*)(a.ws + WS_MIX);
    const float* nw = a.ssd_norm_w + (size_t)layer * 2048 + h * 64;
    f32x4 wv[4];
#pragma unroll
    for (int pb = 0; pb < 4; ++pb) wv[pb] = *(const f32x4*)(nw + pb * 16 + 4 * q4);
#pragma unroll
    for (int lb = 0; lb < 4; ++lb) {
        const int l = lb * 16 + fr; float tot = 0.f;
#pragma unroll
        for (int w2 = 0; w2 < 8; ++w2) tot += SSQ[w2 * 64 + l];
        const float rs = rsqrtf(tot * (1.0f / 512.0f) + EPS);
#pragma unroll
        for (int pb = 0; pb < 4; ++pb) {
            const f32x4 y = acc[pb][lb];
            u32x2 o; o.x = pk2(y[0] * rs * wv[pb][0], y[1] * rs * wv[pb][1]); o.y = pk2(y[2] * rs * wv[pb][2], y[3] * rs * wv[pb][3]);
            *(u32x2*)(mix + (size_t)(t0 + l) * DMIX + h * 64 + pb * 16 + 4 * q4) = o;
        }
    }
    __syncthreads();
}

typedef float f32x2 __attribute__((ext_vector_type(2)));
template <bool MASK> DI void sb_block(const f32x4& zacc, float scale2, int s0, int t, float m1, float m2, float& R, unsigned& w0, unsigned& w1) {
    const f32x2 za = (f32x2){zacc[0], zacc[1]} * scale2, zb = (f32x2){zacc[2], zacc[3]} * scale2;
    f32x2 ea, eb;
    ea.x = __builtin_amdgcn_exp2f(-fabsf(za.x)); ea.y = __builtin_amdgcn_exp2f(-fabsf(za.y)); eb.x = __builtin_amdgcn_exp2f(-fabsf(zb.x)); eb.y = __builtin_amdgcn_exp2f(-fabsf(zb.y));
    const f32x2 ua = ea + 1.0f, ub = eb + 1.0f;
    f32x2 la, lb, ma, mb;
    la.x = __builtin_amdgcn_logf(ua.x); la.y = __builtin_amdgcn_logf(ua.y); lb.x = __builtin_amdgcn_logf(ub.x); lb.y = __builtin_amdgcn_logf(ub.y);
    ma.x = fmaxf(za.x, 0.f); ma.y = fmaxf(za.y, 0.f); mb.x = fmaxf(zb.x, 0.f); mb.y = fmaxf(zb.y, 0.f);
    f32x2 spa = ma + la, spb = mb + lb;
    bool v0 = true, v1 = true, v2 = true, v3 = true;
    if (MASK) { v0 = s0 < t; v1 = s0 + 1 < t; v2 = s0 + 2 < t; v3 = s0 + 3 < t;
        spa.x = v0 ? spa.x : 0.f; spa.y = v1 ? spa.y : 0.f; spb.x = v2 ? spb.x : 0.f; spb.y = v3 ? spb.y : 0.f; }
    const float suf3 = spb.y, suf2 = spb.x + suf3, suf1 = spa.y + suf2, suf0 = spa.x + suf1;
    const auto s16 = __builtin_amdgcn_permlane16_swap(__float_as_uint(suf0), __float_as_uint(suf0), false, false);
    const float po = __uint_as_float(s16[1]);
    const float psum = __uint_as_float(s16[0]) + po;
    const auto s32 = __builtin_amdgcn_permlane32_swap(__float_as_uint(psum), __float_as_uint(psum), false, false);
    const float hlo = __uint_as_float(s32[0]), hhi = __uint_as_float(s32[1]);
    const float nb = -(R + (m1 * po + m2 * hhi));
    R += hlo + hhi;
    const f32x2 aa = (za + nb) - (f32x2){suf0, suf1}, ab = (zb + nb) - (f32x2){suf2, suf3};
    float x0 = __builtin_amdgcn_exp2f(aa.x), x1 = __builtin_amdgcn_exp2f(aa.y), x2 = __builtin_amdgcn_exp2f(ab.x), x3 = __builtin_amdgcn_exp2f(ab.y);
    if (MASK) { x0 = v0 ? x0 : 0.f; x1 = v1 ? x1 : 0.f; x2 = v2 ? x2 : 0.f; x3 = v3 ? x3 : 0.f; }
    w0 = pk2(x0, x1); w1 = pk2(x2, x3);
}

constexpr int NTB = 1, ATT_Q = 128 * NTB;
DI void attn_unit(const Args& a, int h, int qb, LAS unsigned char* lds) {
    const int tid = opaque_tid(), lane = tid & 63, wave = tid >> 6, fr = lane & 15, q4 = lane >> 4;
    const bf16_t* proj = (const bf16_t*)(a.ws + WS_PROJ);
    constexpr int KVB = 64 * TS * 2;
    LAS int* FLG = (LAS int*)(lds + 4 * KVB);
    const int q0 = qb * ATT_Q, tq0 = q0 + wave * 16 * NTB, tmax = tq0 + 16 * NTB - 2;
    const float scale2 = 0.08838834764831845f * 1.4426950408889634f;
    constexpr float THR2 = 151.0f;
    bf16x8 qf[NTB][4];
#pragma unroll
    for (int tb = 0; tb < NTB; ++tb)
#pragma unroll
        for (int ks = 0; ks < 4; ++ks) qf[tb][ks] = *(const bf16x8*)(proj + (size_t)(tq0 + tb * 16 + fr) * NPROJ + QOFF + h * 128 + ks * 32 + q4 * 8);
    f32x4 oacc[NTB][8];
    u32x2 gpre[NTB][8];
#pragma unroll
    for (int tb = 0; tb < NTB; ++tb)
#pragma unroll
        for (int db = 0; db < 8; ++db) {
            oacc[tb][db] = (f32x4){0.f, 0.f, 0.f, 0.f};
            gpre[tb][db] = *(const u32x2*)(proj + (size_t)(tq0 + tb * 16 + fr) * NPROJ + GOFF + h * 128 + db * 16 + 4 * q4);
        }
    float R[NTB];
#pragma unroll
    for (int tb = 0; tb < NTB; ++tb) R[tb] = 0.f;
    const float m1 = (q4 & 1) ? 0.f : 1.f, m2 = (q4 < 2) ? 1.f : 0.f;
    bool fin = false;
    int b = 0;
    const int kt_top = (q0 + ATT_Q - 1) >> 6;
    u32x4 kreg[2], vreg[2];
    const int prow = tid >> 4, pch = tid & 15;
    {
        const bf16_t* src = proj + (size_t)(kt_top * 64 + prow) * NPROJ + h * 128 + pch * 8;
        kreg[0] = *(const u32x4*)(src + KOFF); vreg[0] = *(const u32x4*)(src + VOFF);
        kreg[1] = *(const u32x4*)(src + (size_t)32 * NPROJ + KOFF); vreg[1] = *(const u32x4*)(src + (size_t)32 * NPROJ + VOFF);
    }
    for (int kt = kt_top; kt >= 0; --kt) {
        const int k0 = kt * 64;
        LAS unsigned char* KS = lds + b * 2 * KVB; LAS unsigned char* VS = KS + KVB;
        *(LAS u32x4*)(KS + (prow * TS + pch * 8) * 2) = kreg[0]; *(LAS u32x4*)(KS + ((prow + 32) * TS + pch * 8) * 2) = kreg[1];
        *(LAS u32x4*)(VS + (prow * TS + pch * 8) * 2) = vreg[0]; *(LAS u32x4*)(VS + ((prow + 32) * TS + pch * 8) * 2) = vreg[1];
        if (lane == 0) FLG[b * 8 + wave] = fin ? 1 : 0;
        __syncthreads();
        int allfin = 1;
#pragma unroll
        for (int w2 = 0; w2 < 8; ++w2) allfin &= FLG[b * 8 + w2];
        if (allfin) break;
        if (kt > 0) {
            const bf16_t* src = proj + (size_t)(k0 - 64 + prow) * NPROJ + h * 128 + pch * 8;
            kreg[0] = *(const u32x4*)(src + KOFF); vreg[0] = *(const u32x4*)(src + VOFF);
            kreg[1] = *(const u32x4*)(src + (size_t)32 * NPROJ + KOFF); vreg[1] = *(const u32x4*)(src + (size_t)32 * NPROJ + VOFF);
        }
        if (!fin && k0 <= tmax) {
#pragma unroll
            for (int kk = 1; kk >= 0; --kk) {
                u32x4 wp[NTB];
#pragma unroll
                for (int tb = 0; tb < NTB; ++tb) wp[tb] = (u32x4){0u, 0u, 0u, 0u};
                bool any = false;
#pragma unroll
                for (int half = 1; half >= 0; --half) {
                    const int kb = 2 * kk + half, kbase = k0 + 16 * kb;
                    if (fin || kbase > tmax) continue;
                    any = true;
                    f32x4 z[NTB];
#pragma unroll
                    for (int tb = 0; tb < NTB; ++tb) z[tb] = (f32x4){0.f, 0.f, 0.f, 0.f};
#pragma unroll
                    for (int ks = 0; ks < 4; ++ks) {
                        const bf16x8 kf = *(const LAS bf16x8*)(KS + ((kb * 16 + fr) * TS + ks * 32 + q4 * 8) * 2);
#pragma unroll
                        for (int tb = 0; tb < NTB; ++tb) z[tb] = mfma16(kf, qf[tb][ks], z[tb]);
                    }
                    bool ok = true;
#pragma unroll
                    for (int tb = 0; tb < NTB; ++tb) {
                        const int t = tq0 + tb * 16 + fr;
                        unsigned w0, w1;
                        sb_block<true>(z[tb], scale2, kbase + 4 * q4, t, m1, m2, R[tb], w0, w1);
                        if (half == 0) { wp[tb].x = w0; wp[tb].y = w1; } else { wp[tb].z = w0; wp[tb].w = w1; }
                        ok = ok && (R[tb] >= THR2);
                    }
                    fin = __all(ok);
                }
                if (any) {
#pragma unroll
                    for (int db = 0; db < 8; ++db) {
                        LAS unsigned char* vp = VS + ((kk * 32 + 4 * q4 + (fr >> 2)) * TS + db * 16 + 4 * (fr & 3)) * 2;
                        const s16x4 lo = __builtin_amdgcn_ds_read_tr16_b64_v4i16((LAS s16x4*)vp);
                        const s16x4 hi = __builtin_amdgcn_ds_read_tr16_b64_v4i16((LAS s16x4*)(vp + 16 * TS * 2));
                        bf16x8 vf; vf[0] = lo[0]; vf[1] = lo[1]; vf[2] = lo[2]; vf[3] = lo[3]; vf[4] = hi[0]; vf[5] = hi[1]; vf[6] = hi[2]; vf[7] = hi[3];
#pragma unroll
                        for (int tb = 0; tb < NTB; ++tb) oacc[tb][db] = mfma16(vf, __builtin_bit_cast(bf16x8, wp[tb]), oacc[tb][db]);
                    }
                }
            }
        }
        b ^= 1;
    }
    bf16_t* mix = (bf16_t*)(a.ws + WS_MIX);
#pragma unroll
    for (int tb = 0; tb < NTB; ++tb) {
        const int t = tq0 + tb * 16 + fr;
#pragma unroll
        for (int db = 0; db < 8; ++db) {
            const u32x2 gr = gpre[tb][db];
            const f32x4 o = oacc[tb][db];
            u32x2 ov; ov.x = pk2(o[0] * silu_f(bf_lo(gr.x)), o[1] * silu_f(bf_hi(gr.x))); ov.y = pk2(o[2] * silu_f(bf_lo(gr.y)), o[3] * silu_f(bf_hi(gr.y)));
            *(u32x2*)(mix + (size_t)t * DMIX + 2048 + h * 128 + db * 16 + 4 * q4) = ov;
        }
    }
    __syncthreads();
}

DI void phase_final(const Args& a) {
    const int tid = opaque_tid(), lane = tid & 63, wave = tid >> 6;
    const int gw = blockIdx.x * 8 + wave, NGW = gridDim.x * 8;
    const bf16_t* xb = (const bf16_t*)(a.ws + WS_XB); const float* ssp = (const float*)(a.ws + WS_SSP);
    for (int row = gw; row < S; row += NGW) {
        const float rs = row_rstd(ssp, row);
        const u32x2* xr = (const u32x2*)(xb + (size_t)row * DM) + lane;
        const f32x4* wr = (const f32x4*)a.final_norm_w + lane;
        f32x4* orow = (f32x4*)(a.out + (size_t)row * DM) + lane;
#pragma unroll
        for (int j = 0; j < 8; ++j) {
            const u32x2 xv = xr[64 * j]; const f32x4 w = wr[64 * j];
            f32x4 o; o[0] = bf_lo(xv.x) * rs * w[0]; o[1] = bf_hi(xv.x) * rs * w[1]; o[2] = bf_lo(xv.y) * rs * w[2]; o[3] = bf_hi(xv.y) * rs * w[3];
            orow[64 * j] = o;
        }
    }
}

__global__ void __launch_bounds__(512, 2) hybrid_fwd(Args a) {
    extern __shared__ __attribute__((aligned(16))) unsigned char lds_raw[];
    LAS unsigned char* lds = (LAS unsigned char*)lds_raw;
    const int G = gridDim.x, bx = blockIdx.x;
    volatile LAS unsigned* bst = (volatile LAS unsigned*)(lds + LDS_BYTES - 16);
    if (threadIdx.x < 4) bst[threadIdx.x] = 0u;
    __syncthreads();
    if (bx == 0) for (int i = threadIdx.x; i < 4096; i += 512) ((unsigned*)(a.ws + WS_BAR))[i] = 0u;
    XcdBarrier bar; bar.bar = (unsigned*)(a.ws + WS_BAR); bar.x = xb_xcc_id(); bar.st = bst;
    int vb = bx;
    int rep = 0;
    for (int ph = a.ph_lo; ph < a.ph_hi;) {
        int ptype;
        if (ph == 0) ptype = 1; else if (ph == NPHASE - 1) ptype = 512; else { const int sub = (ph - 1) % 5; ptype = sub == 0 ? 2 : sub == 1 ? (8 | 16) : sub == 2 ? 32 : sub == 3 ? 64 : 128; }
        const bool dummy = (DUPM & ptype) && rep == 0;
        if (ph == 0) {
#if !(SKIPM & 1)
            phase_prologue(a, lds);
#endif
        } else if (ph == NPHASE - 1) {
            phase_final(a);
        } else {
            const int layer = (ph - 1) / 5, sub = (ph - 1) % 5;
            if (sub == 0) {
                pg8::Gemm g; g.A = (const bf16_t*)(a.ws + WS_XB); g.Bt = (const bf16_t*)(a.ws + WS_WIN) + (size_t)layer * NPROJ * DM; g.M = S; g.N = NPROJ; g.K = DM;
                pg8::StaticOrder so; so.init(S, NPROJ, G, vb);
                pg8::EpiInProj e; e.O = (bf16_t*)(a.ws + WS_PROJ); e.ssp = (const float*)(a.ws + WS_SSP);
                {
                    pg8::Unit u0; u0.pm = 0; u0.pn = 0; so.next(0, u0);
                    LAS float* rsl = (LAS float*)(lds + pg8::STAGE_BYTES);
                    const int t_ = opaque_tid();
                    if (t_ < 256) rsl[t_] = row_rstd(e.ssp, u0.pm * 256 + t_);
                    e.rs_lds = rsl; e.pm0 = u0.pm;
                    __syncthreads();
                }
#if !(SKIPM & 2)
                pg8::gemm_phase(lds, g, so, e);
#endif
                const int nfull = (S / 256) * (NPROJ / 256);
                const int rem = nfull % G;
                const int wave = opaque_tid() >> 6;
#if !(SKIPM & 4)
                if (rem == 0 || G - rem < 64) dt_gemm(a, layer, vb, G, lds);
                else if (vb >= rem) dt_gemm(a, layer, vb - rem, G - rem, lds);
#endif
                if (layer + 1 < NL && !dummy) {
                    const int lane = opaque_tid() & 63;
                    LAS float* scr = (LAS float*)(lds + wave * 16896);
                    if (rem == 0 || G - rem < 64) { for (int it = CV_PER_L - CV_SLOT + vb * 8 + wave; it < CV_PER_L; it += G * 8) convert_item(a, layer + 1, it, scr, lane); }
                    else if (vb >= rem) { for (int it = CV_PER_L - CV_SLOT + (vb - rem) * 8 + wave; it < CV_PER_L; it += (G - rem) * 8) convert_item(a, layer + 1, it, scr, lane); }
                }
            } else if (sub == 1) {
#if !(SKIPM & 8)
                if (!(DUPM & 24) || !dummy || (DUPM & 8))
                for (int u = bx; u < 512; u += G) ssd_states_unit(a, layer, u >> 2, u & 3, lds);
#endif
#if !(SKIPM & 16)
                if (!(DUPM & 24) || !dummy || (DUPM & 16))
                for (int u = bx; u < 16 * (S / ATT_Q); u += G) attn_unit(a, u & 15, u >> 4, lds);
#endif
            } else if (sub == 2) {
#if !(SKIPM & 32)
                phase_scan(a, a.ws + (dummy ? WS_END : WS_STATES));
#endif
            } else if (sub == 3) {
#if !(SKIPM & 64)
                for (int u = bx; u < 512; u += G) ssd_out_unit(a, layer, u >> 2, u & 3, lds);
#endif
            } else {
                pg8::Gemm g; g.A = (const bf16_t*)(a.ws + WS_MIX); g.Bt = (const bf16_t*)(a.ws + WS_WOUT) + (size_t)layer * DM * DMIX; g.M = S; g.N = DM; g.K = DMIX;
                pg8::StaticOrder so; so.init(S, DM, G, vb);
                pg8::EpiOutProj e; e.xb = (bf16_t*)(a.ws + WS_XB); e.ssp = (float*)(a.ws + WS_SSP);
#if !(SKIPM & 128)
                pg8::gemm_phase(lds, g, so, e);
#endif
            }
        }
        if (dummy) rep = 1; else { rep = 0; ++ph; }
        if (ph < a.ph_hi) {
            if (ph == 1 && !dummy) {
                cg::this_grid().sync();
                if (threadIdx.x == 0) (void)xb_add(&bar.bar[XB_XCNT(bar.x)], 1u);
            } else xcd_barrier(bar);
        }
    }
#if (DUPM & 256)
    for (int i = 0; i < 20; ++i) cg::this_grid().sync();
#endif
}

extern "C" void kernel_launch(void* const* d_in, const int* in_sizes, int n_in, void* d_out, int out_size, void* d_ws, size_t ws_size, hipStream_t stream) {
    static int grid = 0;
    if (grid == 0) {
        if (n_in != 11 || out_size != S * DM || ws_size < WS_END) { fprintf(stderr, "kernel_launch: unexpected shapes (n_in %d out %d ws %zu need %zu)\n", n_in, out_size, ws_size, (size_t)WS_END); grid = -1; return; }
        int dev = 0, cus = 0, per_cu = 0;
        hipGetDevice(&dev);
        hipDeviceGetAttribute(&cus, hipDeviceAttributeMultiprocessorCount, dev);
        if (hipFuncSetAttribute((const void*)hybrid_fwd, hipFuncAttributeMaxDynamicSharedMemorySize, LDS_BYTES) != hipSuccess) { fprintf(stderr, "kernel_launch: hipFuncSetAttribute failed\n"); grid = -1; return; }
        hipOccupancyMaxActiveBlocksPerMultiprocessor(&per_cu, (const void*)hybrid_fwd, 512, LDS_BYTES);
        (void)hipGetLastError();
        if (per_cu < 1) { fprintf(stderr, "kernel_launch: occupancy query says %d blocks per CU\n", per_cu); per_cu = 1; }
        grid = cus;
        if (grid != 256) fprintf(stderr, "kernel_launch: %d CUs; this build assumes 256\n", grid);
    }
    if (grid < 0) return;
    Args a{};
    a.x = (const float*)d_in[0]; a.norm_w = (const float*)d_in[1]; a.w_in = (const float*)d_in[2]; a.conv_w = (const float*)d_in[3]; a.conv_b = (const float*)d_in[4];
    a.dt_bias = (const float*)d_in[5]; a.a_log = (const float*)d_in[6]; a.d_skip = (const float*)d_in[7]; a.ssd_norm_w = (const float*)d_in[8];
    a.w_out = (const float*)d_in[9]; a.final_norm_w = (const float*)d_in[10];
    a.out = (float*)d_out; a.ws = (unsigned char*)d_ws;
#if ONE_LAUNCH
    a.ph_lo = 0; a.ph_hi = NPHASE;
    void* args[] = {&a};
    hipError_t e = hipLaunchCooperativeKernel((const void*)hybrid_fwd, dim3(grid), dim3(512), args, LDS_BYTES, stream);
    if (e != hipSuccess) fprintf(stderr, "cooperative launch failed: %s (grid %d)\n", hipGetErrorString(e), grid);
#else
    for (int ph = 0; ph < NPHASE; ++ph) {
        a.ph_lo = ph; a.ph_hi = ph + 1;
        hipLaunchKernelGGL(hybrid_fwd, dim3(grid), dim3(512), LDS_BYTES, stream, a);
    }
#endif
}
```

```cpp
#include <hip/hip_runtime.h>
#include <hip/hip_cooperative_groups.h>
#include <cstdio>
#include <cstdint>
namespace cg = cooperative_groups;

#ifndef DUPM
#define DUPM 0
#endif
#ifndef SKIPM
#define SKIPM 0
#endif
#ifndef ONE_LAUNCH
#define ONE_LAUNCH 1
#endif

#define LAS __attribute__((address_space(3)))
#define DI __device__ __forceinline__
typedef unsigned short bf16_t;
typedef short bf16x8 __attribute__((ext_vector_type(8)));
typedef float f32x4 __attribute__((ext_vector_type(4)));
typedef unsigned u32x4 __attribute__((ext_vector_type(4)));
typedef unsigned u32x2 __attribute__((ext_vector_type(2)));

constexpr int S = 8192, DM = 2048, NL = 4, NPROJ = 13312, INCOLS = 13344, DMIX = 4096;
constexpr int ZOFF = 0, XOFF = 2048, BOFF = 4096, COFF = 4608, QOFF = 5120, KOFF = 7168, VOFF = 9216, GOFF = 11264;
constexpr int NCHUNK = 128, NH = 32, CONVD = 3072;
constexpr float EPS = 1e-6f;
constexpr int LDS_BYTES = 147456;
constexpr int NPHASE = 2 + 5 * NL;

constexpr size_t WS_WIN = 0;
constexpr size_t WS_WDT = WS_WIN + (size_t)NL * NPROJ * DM * 2;
constexpr size_t WS_WOUT = WS_WDT + (size_t)NL * 32 * DM * 2;
constexpr size_t WS_XB = WS_WOUT + (size_t)NL * DM * DMIX * 2;
constexpr size_t WS_XRES = WS_XB + (size_t)S * DM * 2;
constexpr size_t WS_PROJ = WS_XRES + (size_t)S * DM * 4;
constexpr size_t WS_DTRAW = WS_PROJ + (size_t)S * NPROJ * 2;
constexpr size_t WS_MIX = WS_DTRAW + (size_t)S * 32 * 4;
constexpr size_t WS_STATES = WS_MIX + (size_t)S * DMIX * 2;
constexpr size_t WS_CDEC = WS_STATES + (size_t)NCHUNK * NH * 64 * 128 * 2;
constexpr size_t WS_SSP = WS_CDEC + (size_t)NCHUNK * NH * 4;
constexpr size_t WS_XACT = WS_SSP + (size_t)8 * S * 4;
constexpr size_t WS_BAR = WS_XACT + (size_t)S * CONVD * 2;
constexpr size_t WS_END = WS_BAR + 16384;

DI unsigned pk2(float lo, float hi) { unsigned r; asm volatile("v_cvt_pk_bf16_f32 %0, %1, %2" : "=v"(r) : "v"(lo), "v"(hi)); return r; }
DI int opaque_tid() { int t = threadIdx.x; asm volatile("" : "+v"(t)); return t; }
DI float bf_lo(unsigned w) { return __uint_as_float(w << 16); }
DI float bf_hi(unsigned w) { return __uint_as_float(w & 0xffff0000u); }
DI float silu_f(float x) { return x * __builtin_amdgcn_rcpf(1.0f + __expf(-x)); }
DI f32x4 mfma16(bf16x8 a, bf16x8 b, f32x4 c) { return __builtin_amdgcn_mfma_f32_16x16x32_bf16(a, b, c, 0, 0, 0); }
typedef short s16x4 __attribute__((ext_vector_type(4)));
DI bf16x8 tr_frag(LAS unsigned char* base, int stride_el, int row0, int col0, int fr) {
    const int q = fr >> 2, p_ = fr & 3;
    LAS unsigned char* p0 = base + ((row0 + q) * stride_el + col0 + 4 * p_) * 2;
    const s16x4 lo = __builtin_amdgcn_ds_read_tr16_b64_v4i16((LAS s16x4*)p0);
    const s16x4 hi = __builtin_amdgcn_ds_read_tr16_b64_v4i16((LAS s16x4*)(p0 + 8 * stride_el));
    bf16x8 r; r[0] = lo[0]; r[1] = lo[1]; r[2] = lo[2]; r[3] = lo[3]; r[4] = hi[0]; r[5] = hi[1]; r[6] = hi[2]; r[7] = hi[3];
    return r;
}
DI float row_rstd(const float* ssp, int row) {
    float s = 0.f;
#pragma unroll
    for (int j = 0; j < 8; ++j) s += ssp[j * S + row];
    return rsqrtf(s * (1.0f / DM) + EPS);
}

namespace pg8 {
constexpr int BM = 256, BK = 64, HALF = 128, HTB = HALF * BK * 2, STAGE_BYTES = 8 * HTB, NXCD = 8, WGM = 8;
DI int lds_byte(int r, int c) { const int st = (r >> 4) * 2 + (c >> 5), rr = r & 15, cc = c & 31, ob = rr * 64 + cc * 2; return st * 1024 + (ob ^ (((ob >> 9) & 1) << 5)); }
DI void stage_rc(int b, int& R, int& C) { const int st = b / 1024, sb = b % 1024, swz = sb ^ (((sb >> 9) & 1) << 5); R = (st >> 1) * 16 + swz / 64; C = (st & 1) * 32 + (swz % 64) / 2; }
DI int perm32(int rho) { const int n = rho >> 4, i = rho & 15; return 8 * (i >> 2) + 4 * n + (i & 3); }
struct Unit { int pm, pn; };
struct Gemm { const bf16_t* A; const bf16_t* Bt; int M, N, K; };
struct StaticOrder {
    int nM, nN, nwg, G, c;
    DI void init(int M, int N, int G_, int c_) { nM = M / BM; nN = N / BM; nwg = nM * nN; G = G_; c = c_; }
    DI bool next(int i, Unit& u) const {
        const long L = (long)i * G + c; if (L >= nwg) return false;
        int wgid = (int)L; { const int q = nwg / NXCD, r = nwg % NXCD, xcd = wgid % NXCD, off = wgid / NXCD; wgid = (xcd < r ? xcd * (q + 1) : r * (q + 1) + (xcd - r) * q) + off; }
        const int nig = WGM * nN, gid = wgid / nig, fm = gid * WGM, gsz = (nM - fm) < WGM ? (nM - fm) : WGM;
        u.pm = fm + ((wgid % nig) % gsz); u.pn = (wgid % nig) / gsz; return true;
    }
};

template <class Epi>
DI void gemm_phase(LAS unsigned char* lds, const Gemm g, const StaticOrder& S_, const Epi& E) {
    const int tid = opaque_tid(), wid = __builtin_amdgcn_readfirstlane(tid >> 6), lane = tid & 63, wr = wid >> 2, wc = wid & 3, fr = lane & 15, fq = lane >> 4;
    const int K = g.K, nt = K / BK;
    unsigned voffA[2], voffB[2];
#pragma unroll
    for (int i = 0; i < 2; ++i) { int R, C; stage_rc(tid * 16 + i * 8192, R, C); const int Rb = Epi::PERM ? ((R & ~31) + perm32(R & 31)) : R;
        voffA[i] = (unsigned)(R * K + C) * 2u; voffB[i] = (unsigned)(Rb * K + C) * 2u; }
    const size_t kstep = (size_t)(BK * 2);
    const size_t hstep = (size_t)HALF * K * 2;
    const size_t tstep = 2 * hstep;
    const unsigned ldsw = (unsigned)wid * 1024u;
    const int aoff = lds_byte(wr * 64 + fr, fq * 8), boff = lds_byte(wc * 32 + fr, fq * 8);
#define PG8_SA(b, h) (((b) * 2 + (h)) * HTB)
#define PG8_SB(b, h) ((4 + (b) * 2 + (h)) * HTB)
#define PG8_STAGE(bufoff, gbase, voff) do { _Pragma("unroll") for (int _i = 0; _i < 2; ++_i) \
        __builtin_amdgcn_global_load_lds((const unsigned*)((const char*)(gbase) + (voff)[_i]), (LAS unsigned*)(lds + (bufoff) + ldsw + _i * 8192), 16, 0, 0); } while (0)
#define PG8_LDA(dst, b, h) do { _Pragma("unroll") for (int m = 0; m < 4; ++m) _Pragma("unroll") for (int k = 0; k < 2; ++k) dst[m][k] = *(const LAS bf16x8*)(lds + PG8_SA(b, h) + aoff + m * 2048 + k * 1024); } while (0)
#define PG8_LDB(dst, b, h) do { _Pragma("unroll") for (int n = 0; n < 2; ++n) _Pragma("unroll") for (int k = 0; k < 2; ++k) dst[n][k] = *(const LAS bf16x8*)(lds + PG8_SB(b, h) + boff + n * 2048 + k * 1024); } while (0)
#define PG8_MMA(ai, bj, At, Bt) do { __builtin_amdgcn_s_setprio(1); _Pragma("unroll") for (int m = 0; m < 4; ++m) _Pragma("unroll") for (int n = 0; n < 2; ++n) _Pragma("unroll") for (int k = 0; k < 2; ++k) \
        acc[ai][bj][m][n] = __builtin_amdgcn_mfma_f32_16x16x32_bf16(Bt[n][k], At[m][k], acc[ai][bj][m][n], 0, 0, 0); __builtin_amdgcn_s_setprio(0); } while (0)
#define PG8_WAIT_V(n) asm volatile("s_waitcnt vmcnt(" #n ")" ::: "memory")
#define PG8_WAIT_L(n) asm volatile("s_waitcnt lgkmcnt(" #n ")" ::: "memory")
#define PG8_BAR __builtin_amdgcn_s_barrier()
#define PG8_SCHED __builtin_amdgcn_sched_barrier(0)
    Unit cur, nxt; int ui = 0;
    if (!S_.next(0, cur)) return;
    f32x4 acc[2][2][4][2];
#pragma unroll
    for (int a = 0; a < 2; ++a)
#pragma unroll
        for (int b = 0; b < 2; ++b)
#pragma unroll
            for (int m = 0; m < 4; ++m)
#pragma unroll
                for (int n = 0; n < 2; ++n) acc[a][b][m][n] = (f32x4){0.f, 0.f, 0.f, 0.f};
    bf16x8 At[4][2], B0[2][2], B1[2][2];
    const char* cA = (const char*)g.A + (size_t)cur.pm * tstep; const char* cB = (const char*)g.Bt + (size_t)cur.pn * tstep;
    PG8_STAGE(PG8_SB(0, 0), cB, voffB); PG8_STAGE(PG8_SA(0, 0), cA, voffA); PG8_STAGE(PG8_SB(0, 1), cB + hstep, voffB); PG8_STAGE(PG8_SA(0, 1), cA + hstep, voffA);
    if (wr == 1) PG8_BAR;
    PG8_WAIT_V(4); PG8_BAR;
    PG8_STAGE(PG8_SB(1, 0), cB + kstep, voffB); PG8_STAGE(PG8_SA(1, 0), cA + kstep, voffA); PG8_STAGE(PG8_SB(1, 1), cB + hstep + kstep, voffB);
    PG8_WAIT_V(6); PG8_BAR;
    for (;;) {
        const bool has_next = S_.next(ui + 1, nxt);
        const char* nA = has_next ? (const char*)g.A + (size_t)nxt.pm * tstep : cA; const char* nB = has_next ? (const char*)g.Bt + (size_t)nxt.pn * tstep : cB;
        for (int t = 0; t < nt; t += 2) {
            const bool last = (t == nt - 2);
            const char* a1 = cA + (size_t)(t + 1) * kstep;
            const char* a2 = last ? nA : cA + (size_t)(t + 2) * kstep; const char* b2 = last ? nB : cB + (size_t)(t + 2) * kstep;
            const char* a3 = a2 + kstep; const char* b3 = b2 + kstep;
            PG8_LDB(B0, 0, 0); PG8_SCHED; PG8_LDA(At, 0, 0); PG8_STAGE(PG8_SA(1, 1), a1 + hstep, voffA);
            PG8_WAIT_L(8); PG8_BAR; PG8_WAIT_L(0); PG8_MMA(0, 0, At, B0); PG8_BAR; PG8_SCHED;
            PG8_LDB(B1, 0, 1); PG8_STAGE(PG8_SB(0, 0), b2, voffB);
            PG8_BAR; PG8_WAIT_L(0); PG8_MMA(0, 1, At, B1); PG8_BAR;
            PG8_LDA(At, 0, 1); PG8_STAGE(PG8_SA(0, 0), a2, voffA);
            PG8_BAR; PG8_WAIT_L(0); PG8_MMA(1, 0, At, B0); PG8_BAR; PG8_SCHED;
            PG8_STAGE(PG8_SB(0, 1), b2 + hstep, voffB);
            PG8_WAIT_V(6); PG8_BAR; PG8_MMA(1, 1, At, B1); PG8_BAR;
            PG8_LDB(B0, 1, 0); PG8_SCHED; PG8_LDA(At, 1, 0); PG8_STAGE(PG8_SA(0, 1), a2 + hstep, voffA);
            PG8_WAIT_L(8); PG8_BAR; PG8_WAIT_L(0); PG8_MMA(0, 0, At, B0); PG8_BAR; PG8_SCHED;
            PG8_LDB(B1, 1, 1); PG8_STAGE(PG8_SB(1, 0), b3, voffB);
            PG8_BAR; PG8_WAIT_L(0); PG8_MMA(0, 1, At, B1); PG8_BAR;
            PG8_LDA(At, 1, 1); PG8_STAGE(PG8_SA(1, 0), a3, voffA);
            PG8_BAR; PG8_WAIT_L(0); PG8_MMA(1, 0, At, B0); PG8_BAR; PG8_SCHED;
            PG8_STAGE(PG8_SB(1, 1), b3 + hstep, voffB);
            PG8_WAIT_V(6); PG8_BAR; PG8_MMA(1, 1, At, B1); PG8_BAR;
        }
        if constexpr (!Epi::AFTER_DRAIN) { E(acc, cur, wr, wc, fr, fq); }
        if (!has_next) break;
#pragma unroll
        for (int a = 0; a < 2; ++a)
#pragma unroll
            for (int b = 0; b < 2; ++b)
#pragma unroll
                for (int m = 0; m < 4; ++m)
#pragma unroll
                    for (int n = 0; n < 2; ++n) acc[a][b][m][n] = (f32x4){0.f, 0.f, 0.f, 0.f};
        cur = nxt; cA = nA; cB = nB; ++ui;
    }
    PG8_WAIT_V(0);
    if (wr == 0) PG8_BAR;
    PG8_BAR;
    if constexpr (Epi::AFTER_DRAIN) { E.fused(acc, cur, wr, wc, fr, fq, lds, wid, lane); }
#undef PG8_SA
#undef PG8_SB
#undef PG8_STAGE
#undef PG8_LDA
#undef PG8_LDB
#undef PG8_MMA
#undef PG8_WAIT_V
#undef PG8_WAIT_L
#undef PG8_BAR
#undef PG8_SCHED
}

struct EpiInProj {
    static constexpr bool PERM = true, AFTER_DRAIN = false;
    bf16_t* O; const float* ssp; const LAS float* rs_lds; int pm0;
    DI void operator()(const f32x4 (&acc)[2][2][4][2], const Unit& u, int wr, int wc, int fr, int fq) const {
        const int row0 = u.pm * BM + wr * 64 + fr; const int col0 = u.pn * BM + wc * 32 + 8 * fq;
        const bool lds_ok = (u.pm == pm0);
#pragma unroll
        for (int ai = 0; ai < 2; ++ai)
#pragma unroll
            for (int m = 0; m < 4; ++m) {
                const int row = row0 + ai * HALF + m * 16;
                const float rs = lds_ok ? rs_lds[wr * 64 + fr + ai * HALF + m * 16] : row_rstd(ssp, row);
                bf16_t* rowp = O + (size_t)row * NPROJ + col0;
#pragma unroll
                for (int bj = 0; bj < 2; ++bj) {
                    const f32x4 v0 = acc[ai][bj][m][0] * rs, v1 = acc[ai][bj][m][1] * rs;
                    u32x4 w; w.x = pk2(v0[0], v0[1]); w.y = pk2(v0[2], v0[3]); w.z = pk2(v1[0], v1[1]); w.w = pk2(v1[2], v1[3]);
                    *(u32x4*)(rowp + bj * HALF) = w;
                }
            }
    }
};
struct EpiOutProj {
    static constexpr bool PERM = true, AFTER_DRAIN = true;
    bf16_t* xb; float* ssp;
    DI void operator()(const f32x4 (&)[2][2][4][2], const Unit&, int, int, int, int) const {}
    DI void fused(const f32x4 (&acc)[2][2][4][2], const Unit& u, int wr, int wc, int fr, int fq, LAS unsigned char* lds, int wid, int lane) const {
        LAS float* red = (LAS float*)lds;
        const int row0 = u.pm * BM + wr * 64 + fr; const int col0 = u.pn * BM + wc * 32 + 8 * fq;
        u32x4 xo[2][4][2];
#pragma unroll
        for (int ai = 0; ai < 2; ++ai)
#pragma unroll
            for (int m = 0; m < 4; ++m)
#pragma unroll
                for (int bj = 0; bj < 2; ++bj) xo[ai][m][bj] = *(const u32x4*)(xb + (size_t)(row0 + ai * HALF + m * 16) * DM + col0 + bj * HALF);
#pragma unroll
        for (int ai = 0; ai < 2; ++ai)
#pragma unroll
            for (int m = 0; m < 4; ++m) {
                const int row = row0 + ai * HALF + m * 16; float ss = 0.f;
#pragma unroll
                for (int bj = 0; bj < 2; ++bj) {
                    const u32x4 o = xo[ai][m][bj];
                    const f32x4 a0 = acc[ai][bj][m][0], a1 = acc[ai][bj][m][1];
                    u32x4 pb;
                    pb.x = pk2(bf_lo(o.x) + a0[0], bf_hi(o.x) + a0[1]); pb.y = pk2(bf_lo(o.y) + a0[2], bf_hi(o.y) + a0[3]);
                    pb.z = pk2(bf_lo(o.z) + a1[0], bf_hi(o.z) + a1[1]); pb.w = pk2(bf_lo(o.w) + a1[2], bf_hi(o.w) + a1[3]);
                    *(u32x4*)(xb + (size_t)row * DM + col0 + bj * HALF) = pb;
                    const float y0 = bf_lo(pb.x), y1 = bf_hi(pb.x), y2 = bf_lo(pb.y), y3 = bf_hi(pb.y), y4 = bf_lo(pb.z), y5 = bf_hi(pb.z), y6 = bf_lo(pb.w), y7 = bf_hi(pb.w);
                    ss += ((y0 * y0 + y1 * y1) + (y2 * y2 + y3 * y3)) + ((y4 * y4 + y5 * y5) + (y6 * y6 + y7 * y7));
                }
                ss += __shfl_xor(ss, 16); ss += __shfl_xor(ss, 32);
                if (fq == 0) red[wc * 256 + wr * 64 + fr + ai * HALF + m * 16] = ss;
            }
        __syncthreads();
        const int tid = opaque_tid();
        if (tid < 256) ssp[(size_t)u.pn * S + u.pm * BM + tid] = (red[tid] + red[256 + tid]) + (red[512 + tid] + red[768 + tid]);
        __syncthreads();
    }
};
}

#define XB_TMO      128
#define XB_XCNT(j)  (256  + 64 * (j))
#define XB_XSUB(j)  (1280 + 64 * (j))
#define XB_XGEN(j)  (2304 + 64 * (j))
#define XB_TOP      3328
#define XB_TOPGEN   3392
#define XCD_BAR_WORDS 3456
#define XB_SPIN_CAP (1u << 20)
DI unsigned xb_ld(unsigned* p)              { return __hip_atomic_load(p, __ATOMIC_RELAXED, __HIP_MEMORY_SCOPE_AGENT); }
DI unsigned xb_add(unsigned* p, unsigned v) { return __hip_atomic_fetch_add(p, v, __ATOMIC_RELAXED, __HIP_MEMORY_SCOPE_AGENT); }
DI unsigned xb_xcc_id() { return (unsigned)__builtin_amdgcn_s_getreg((3 << 11) | 20) & 0xFu; }
#define XB_SPIN(cond, bar) do { unsigned _sp = 0; while (cond) { __builtin_amdgcn_s_sleep(1); \
    if ((++_sp & 255u) == 0u) { if (xb_ld(&(bar)[XB_TMO])) break; if (_sp > XB_SPIN_CAP) { atomicAdd(&(bar)[XB_TMO], 1u); break; } } } } while (0)
struct XcdBarrier { unsigned* bar; unsigned x; volatile LAS unsigned* st; };
DI XcdBarrier xcd_barrier_post(unsigned* bar, volatile LAS unsigned* st) {
    XcdBarrier b; b.bar = bar; b.x = xb_xcc_id(); b.st = st;
    if (threadIdx.x == 0) st[2] = xb_add(&bar[XB_XCNT(b.x)], 1u);
    return b;
}
DI void xcd_barrier_complete(unsigned* bar, unsigned x, unsigned& nloc, unsigned& nx) {
    const unsigned G = gridDim.x * gridDim.y * gridDim.z;
    unsigned sum, cnt, mine, sp = 0u;
    for (;;) {
        sum = 0u; cnt = 0u; mine = 0u;
#pragma unroll
        for (unsigned j = 0; j < 16; ++j) { const unsigned c = xb_ld(&bar[XB_XCNT(j)]); sum += c; cnt += (c > 0u) ? 1u : 0u; mine = (j == x) ? c : mine; }
        if (sum == G) break;
        __builtin_amdgcn_s_sleep(1);
        if ((++sp & 255u) == 0u) { if (xb_ld(&bar[XB_TMO])) break; if (sp > XB_SPIN_CAP) { atomicAdd(&bar[XB_TMO], 1u); break; } }
    }
    nloc = mine > 0u ? mine : 1u; nx = cnt > 0u ? cnt : 1u;
}
DI void xcd_barrier(const XcdBarrier& b) {
    asm volatile("s_waitcnt vmcnt(0)" ::: "memory");
    __syncthreads();
    if (threadIdx.x == 0) {
        unsigned* bar = b.bar;
        __builtin_amdgcn_s_waitcnt(0);
        unsigned nloc = b.st[0], nx = b.st[1];
        if (nloc == 0u) { xcd_barrier_complete(bar, b.x, nloc, nx); b.st[0] = nloc; b.st[1] = nx; }
        const unsigned old = xb_add(&bar[XB_XSUB(b.x)], 1u);
        const unsigned gen = old / nloc;
        if (old + 1u == (gen + 1u) * nloc) {
            __builtin_amdgcn_fence(__ATOMIC_RELEASE, "agent");
            asm volatile("s_waitcnt vmcnt(0)" ::: "memory");
            const unsigned og = xb_add(&bar[XB_TOP], 1u);
            const unsigned tg = og / nx;
            if (og + 1u == (tg + 1u) * nx) xb_add(&bar[XB_TOPGEN], 1u);
            else XB_SPIN(xb_ld(&bar[XB_TOPGEN]) == tg, bar);
            __builtin_amdgcn_fence(__ATOMIC_ACQUIRE, "agent");
            xb_add(&bar[XB_XGEN(b.x)], 1u);
            asm volatile("s_waitcnt vmcnt(0)" ::: "memory");
        } else {
            XB_SPIN(xb_ld(&bar[XB_XGEN(b.x)]) == gen, bar);
            __builtin_amdgcn_fence(__ATOMIC_ACQUIRE, "agent");
            asm volatile("s_waitcnt vmcnt(0)" ::: "memory");
        }
    }
    __syncthreads();
}

struct Args {
    const float* x; const float* norm_w; const float* w_in; const float* conv_w; const float* conv_b;
    const float* dt_bias; const float* a_log; const float* d_skip; const float* ssd_norm_w; const float* w_out; const float* final_norm_w;
    float* out; unsigned char* ws; int ph_lo, ph_hi;
};

DI void conv_load(const bf16_t* proj, int t0, int l0, int cc, u32x4 (&raw)[7]) {
#pragma unroll
    for (int i = 0; i < 7; ++i) {
        const int t = t0 + l0 - 3 + i;
        if (t >= 0) raw[i] = *(const u32x4*)(proj + (size_t)t * NPROJ + XOFF + cc);
        else raw[i] = (u32x4){0u, 0u, 0u, 0u};
    }
}
DI void conv_compute(const u32x4 (&raw)[7], const float* cw, const float* cb, int cc, float (&out)[4][8]) {
    float w[4][8], b[8];
#pragma unroll
    for (int j = 0; j < 4; ++j) {
        const f32x4 w0 = *(const f32x4*)(cw + j * CONVD + cc), w1 = *(const f32x4*)(cw + j * CONVD + cc + 4);
        w[j][0] = w0[0]; w[j][1] = w0[1]; w[j][2] = w0[2]; w[j][3] = w0[3]; w[j][4] = w1[0]; w[j][5] = w1[1]; w[j][6] = w1[2]; w[j][7] = w1[3];
    }
    { const f32x4 b0 = *(const f32x4*)(cb + cc), b1 = *(const f32x4*)(cb + cc + 4);
      b[0] = b0[0]; b[1] = b0[1]; b[2] = b0[2]; b[3] = b0[3]; b[4] = b1[0]; b[5] = b1[1]; b[6] = b1[2]; b[7] = b1[3]; }
#pragma unroll
    for (int i = 0; i < 4; ++i)
#pragma unroll
        for (int e = 0; e < 8; ++e) {
            float a = b[e];
#pragma unroll
            for (int j = 0; j < 4; ++j) {
                const unsigned wd = raw[i + j][e >> 1];
                a += w[j][e] * ((e & 1) ? bf_hi(wd) : bf_lo(wd));
            }
            out[i][e] = silu_f(a);
        }
}

DI void head_dt(const float* dtraw, const float* dt_bias, const float* a_log, int t0, int h, int lane, float& dtv, float& acum) {
    const float xr = dtraw[(size_t)(t0 + lane) * 32 + h] + dt_bias[h];
    dtv = (xr > 20.f) ? xr : log1pf(expf(xr));
    const float A = -expf(a_log[h]);
    float v = dtv * A;
#pragma unroll
    for (int o = 1; o < 64; o <<= 1) { const float t = __shfl_up(v, o); if (lane >= o) v += t; }
    acum = v;
}

DI void transpose_item(const float* W, int Nsrc, int k0, int n0, const float* nw, bf16_t* dst, int Kdst, LAS float* scr, int lane) {
    f32x4 v[16]; float sc[16];
#pragma unroll
    for (int i = 0; i < 16; ++i) {
        const int kk = 8 * i + (lane >> 3);
        v[i] = __builtin_nontemporal_load((const f32x4*)(W + (size_t)(k0 + kk) * Nsrc + n0 + 4 * (lane & 7)));
        sc[i] = nw ? nw[k0 + kk] : 1.0f;
    }
#pragma unroll
    for (int i = 0; i < 16; ++i) {
        const int kk = 8 * i + (lane >> 3);
        LAS float* p = scr + kk * 33 + 4 * (lane & 7);
        p[0] = v[i][0] * sc[i]; p[1] = v[i][1] * sc[i]; p[2] = v[i][2] * sc[i]; p[3] = v[i][3] * sc[i];
    }
    asm volatile("s_waitcnt lgkmcnt(0)" ::: "memory");
    const int c = lane & 15;
#pragma unroll
    for (int j = 0; j < 8; ++j) {
        const int n = (lane >> 4) + 4 * j; const LAS float* s = scr + (8 * c) * 33 + n;
        u32x4 o; o.x = pk2(s[0 * 33], s[1 * 33]); o.y = pk2(s[2 * 33], s[3 * 33]); o.z = pk2(s[4 * 33], s[5 * 33]); o.w = pk2(s[6 * 33], s[7 * 33]);
        *(u32x4*)(dst + (size_t)n * Kdst + k0 + 8 * c) = o;
    }
    asm volatile("s_waitcnt lgkmcnt(0)" ::: "memory");
}

constexpr int CV_IN_ITEMS = 16 * 417, CV_OUT_ITEMS = 32 * 64, CV_PER_L = CV_IN_ITEMS + CV_OUT_ITEMS;
#ifndef CV_SLOT_N
#define CV_SLOT_N 8720
#endif
constexpr int CV_SLOT = CV_SLOT_N;
DI void convert_item(const Args& a, int l, int r, LAS float* scr, int lane) {
    bf16_t* win = (bf16_t*)(a.ws + WS_WIN); bf16_t* wdt = (bf16_t*)(a.ws + WS_WDT); bf16_t* wout = (bf16_t*)(a.ws + WS_WOUT);
    if (r < CV_IN_ITEMS) {
        const int nb = r % 417, kb = r / 417; const int n0 = nb * 32;
        bf16_t* dst;
        if (nb < 160) dst = win + ((size_t)l * NPROJ + n0) * DM;
        else if (nb == 160) dst = wdt + (size_t)l * 32 * DM;
        else dst = win + ((size_t)l * NPROJ + n0 - 32) * DM;
        transpose_item(a.w_in + (size_t)l * DM * INCOLS, INCOLS, kb * 128, n0, a.norm_w + l * DM, dst, DM, scr, lane);
    } else {
        r -= CV_IN_ITEMS; const int nb = r % 64, kb = r / 64;
        transpose_item(a.w_out + (size_t)l * DMIX * DM, DM, kb * 128, nb * 32, nullptr, wout + ((size_t)l * DM + nb * 32) * DMIX, DMIX, scr, lane);
    }
}

DI void phase_prologue(const Args& a, LAS unsigned char* lds) {
    const int tid = opaque_tid(), lane = tid & 63, wave = tid >> 6;
    const int gw = blockIdx.x * 8 + wave, NGW = gridDim.x * 8;
    LAS float* scr = (LAS float*)(lds + wave * 16896);
    constexpr int PRO_ITEMS = CV_PER_L + (NL - 1) * (CV_PER_L - CV_SLOT);
    for (int it = gw; it < PRO_ITEMS; it += NGW) {
        if (it < CV_PER_L) convert_item(a, 0, it, scr, lane);
        else { const int j = it - CV_PER_L; convert_item(a, 1 + j / (CV_PER_L - CV_SLOT), j % (CV_PER_L - CV_SLOT), scr, lane); }
    }
    bf16_t* xb = (bf16_t*)(a.ws + WS_XB); float* ssp = (float*)(a.ws + WS_SSP);
    for (int row = gw; row < S; row += NGW) {
        const f32x4* xr = (const f32x4*)(a.x + (size_t)row * DM) + lane;
        float ss = 0.f;
#pragma unroll
        for (int j = 0; j < 8; ++j) {
            const f32x4 v = xr[64 * j];
            ss += (v[0] * v[0] + v[1] * v[1]) + (v[2] * v[2] + v[3] * v[3]);
            u32x2 pb; pb.x = pk2(v[0], v[1]); pb.y = pk2(v[2], v[3]);
            *(u32x2*)(xb + (size_t)row * DM + 256 * j + 4 * lane) = pb;
        }
#pragma unroll
        for (int o = 1; o < 64; o <<= 1) ss += __shfl_xor(ss, o);
        if (lane < 8) ssp[lane * S + row] = (lane == 0) ? ss : 0.f;
    }
}

DI void dt_gemm(const Args& a, int layer, int blk, int nblk, LAS unsigned char* lds) {
    const int tid = opaque_tid(), lane = tid & 63, wave = tid >> 6, fr = lane & 15, q4 = lane >> 4;
    const bf16_t* xb = (const bf16_t*)(a.ws + WS_XB); const bf16_t* wdt = (const bf16_t*)(a.ws + WS_WDT) + (size_t)layer * 32 * DM;
    const float* ssp = (const float*)(a.ws + WS_SSP); float* dtraw = (float*)(a.ws + WS_DTRAW);
    LAS float* P = (LAS float*)lds;
    for (int tg = blk; tg < S / 64; tg += nblk) {
        const int row0 = tg * 64, kw = wave * 256;
        bf16x8 b0[8], b1[8];
#pragma unroll
        for (int ks = 0; ks < 8; ++ks) {
            b0[ks] = *(const bf16x8*)(wdt + (size_t)fr * DM + kw + ks * 32 + q4 * 8);
            b1[ks] = *(const bf16x8*)(wdt + (size_t)(16 + fr) * DM + kw + ks * 32 + q4 * 8);
        }
#pragma unroll
        for (int t = 0; t < 4; ++t) {
            bf16x8 av[8];
#pragma unroll
            for (int ks = 0; ks < 8; ++ks) av[ks] = *(const bf16x8*)(xb + (size_t)(row0 + 16 * t + fr) * DM + kw + ks * 32 + q4 * 8);
            f32x4 acc0 = {0.f, 0.f, 0.f, 0.f}, acc1 = {0.f, 0.f, 0.f, 0.f};
#pragma unroll
            for (int ks = 0; ks < 8; ++ks) { acc0 = mfma16(av[ks], b0[ks], acc0); acc1 = mfma16(av[ks], b1[ks], acc1); }
#pragma unroll
            for (int r = 0; r < 4; ++r) { P[(((wave * 4 + t) * 2 + 0) * 4 + r) * 64 + lane] = acc0[r]; P[(((wave * 4 + t) * 2 + 1) * 4 + r) * 64 + lane] = acc1[r]; }
        }
        __syncthreads();
#pragma unroll
        for (int i = 0; i < 4; ++i) {
            const int o = tid + 512 * i;
            const int ln = o & 63, r = (o >> 6) & 3, j = (o >> 8) & 1, t = o >> 9;
            float sum = 0.f;
#pragma unroll
            for (int w = 0; w < 8; ++w) sum += P[w * 2048 + o];
            const int row = row0 + 16 * t + 4 * (ln >> 4) + r;
            dtraw[(size_t)row * 32 + 16 * j + (ln & 15)] = sum * row_rstd(ssp, row);
        }
        __syncthreads();
    }
}

constexpr int TS = 136, XS_STR = 520;
DI void ssd_states_unit(const Args& a, int layer, int c, int g, LAS unsigned char* lds) {
    const int tid = opaque_tid(), lane = tid & 63, wave = tid >> 6, fr = lane & 15, q4 = lane >> 4;
    const int t0 = c * 64, h = g * 8 + wave;
    const bf16_t* proj = (const bf16_t*)(a.ws + WS_PROJ);
    bf16_t* xact = (bf16_t*)(a.ws + WS_XACT);
    LAS unsigned char* BS = lds;
    LAS unsigned char* XS = lds + 64 * TS * 2;
    LAS float* WL = (LAS float*)(lds + 64 * TS * 2 + 64 * XS_STR * 2);
    {
        float dtv, ac;
        head_dt((const float*)(a.ws + WS_DTRAW), a.dt_bias + layer * NH, a.a_log + layer * NH, t0, h, lane, dtv, ac);
        const float alast = __shfl(ac, 63);
        WL[wave * 64 + lane] = __expf(alast - ac) * dtv;
        if (lane == 0) ((float*)(a.ws + WS_CDEC))[c * NH + h] = __expf(alast);
    }
    __syncthreads();
    const float* cw = a.conv_w + (size_t)layer * 4 * CONVD; const float* cb = a.conv_b + (size_t)layer * CONVD;
    u32x4 raw3[3][7];
#pragma unroll
    for (int k = 0; k < 3; ++k) {
        const int it = tid + 512 * k, cgi = it % 96, l0 = (it / 96) * 4;
        const int cc = (cgi < 64) ? g * 512 + cgi * 8 : (cgi < 80) ? 2048 + g * 128 + (cgi - 64) * 8 : 2560 + g * 128 + (cgi - 80) * 8;
        conv_load(proj, t0, l0, cc, raw3[k]);
    }
#pragma unroll
    for (int k = 0; k < 3; ++k) {
        const int it = tid + 512 * k;
        const int cgi = it % 96, l0 = (it / 96) * 4;
        const int cc = (cgi < 64) ? g * 512 + cgi * 8 : (cgi < 80) ? 2048 + g * 128 + (cgi - 64) * 8 : 2560 + g * 128 + (cgi - 80) * 8;
        float o[4][8];
        conv_compute(raw3[k], cw, cb, cc, o);
#pragma unroll
        for (int i = 0; i < 4; ++i) {
            u32x4 v; v.x = pk2(o[i][0], o[i][1]); v.y = pk2(o[i][2], o[i][3]); v.z = pk2(o[i][4], o[i][5]); v.w = pk2(o[i][6], o[i][7]);
            *(u32x4*)(xact + (size_t)(t0 + l0 + i) * CONVD + cc) = v;
            if (cgi >= 64 && cgi < 80) *(LAS u32x4*)(BS + ((l0 + i) * TS + (cgi - 64) * 8) * 2) = v;
        }
        if (cgi < 64) {
            const int hd = cgi >> 3;
#pragma unroll
            for (int i = 0; i < 4; ++i) {
                const float w = WL[hd * 64 + l0 + i];
                u32x4 v; v.x = pk2(o[i][0] * w, o[i][1] * w); v.y = pk2(o[i][2] * w, o[i][3] * w); v.z = pk2(o[i][4] * w, o[i][5] * w); v.w = pk2(o[i][6] * w, o[i][7] * w);
                *(LAS u32x4*)(XS + ((l0 + i) * XS_STR + cgi * 8) * 2) = v;
            }
        }
    }
    __syncthreads();
    f32x4 acc[8][4];
#pragma unroll
    for (int nb = 0; nb < 8; ++nb)
#pragma unroll
        for (int pb = 0; pb < 4; ++pb) acc[nb][pb] = (f32x4){0.f, 0.f, 0.f, 0.f};
#pragma unroll
    for (int ks = 0; ks < 2; ++ks) {
        bf16x8 xf[4];
#pragma unroll
        for (int pb = 0; pb < 4; ++pb) xf[pb] = tr_frag(XS, XS_STR, ks * 32 + q4 * 8, wave * 64 + pb * 16, fr);
#pragma unroll
        for (int nb = 0; nb < 8; ++nb) {
            const bf16x8 bfr = tr_frag(BS, TS, ks * 32 + q4 * 8, nb * 16, fr);
#pragma unroll
            for (int pb = 0; pb < 4; ++pb) acc[nb][pb] = mfma16(bfr, xf[pb], acc[nb][pb]);
        }
    }
    bf16_t* st = (bf16_t*)(a.ws + WS_STATES) + ((size_t)(c * NH + h) * 64) * 128;
#pragma unroll
    for (int nb = 0; nb < 8; ++nb)
#pragma unroll
        for (int pb = 0; pb < 4; ++pb) {
            u32x2 v; v.x = pk2(acc[nb][pb][0], acc[nb][pb][1]); v.y = pk2(acc[nb][pb][2], acc[nb][pb][3]);
            *(u32x2*)(st + (size_t)(pb * 16 + fr) * 128 + nb * 16 + 4 * q4) = v;
        }
    __syncthreads();
}

DI void phase_scan(const Args& a, unsigned char* states_base) {
    const int gt = blockIdx.x * 512 + opaque_tid(), NT = gridDim.x * 512;
    unsigned* st = (unsigned*)states_base; const float* cdec = (const float*)(a.ws + WS_CDEC);
    constexpr int PAIRS = NH * 64 * 128 / 2;
    for (int e = gt; e < PAIRS; e += NT) {
        const int h = e >> 12;
        float r0 = 0.f, r1 = 0.f;
        for (int c0 = 0; c0 < NCHUNK; c0 += 8) {
            unsigned v[8]; float d[8];
#pragma unroll
            for (int j = 0; j < 8; ++j) { v[j] = st[(size_t)(c0 + j) * PAIRS + e]; d[j] = cdec[(c0 + j) * NH + h]; }
#pragma unroll
            for (int j = 0; j < 8; ++j) {
                st[(size_t)(c0 + j) * PAIRS + e] = pk2(r0, r1);
                r0 = r0 * d[j] + bf_lo(v[j]); r1 = r1 * d[j] + bf_hi(v[j]);
            }
        }
    }
}

DI void ssd_out_unit(const Args& a, int layer, int c, int g, LAS unsigned char* lds) {
    const int tid = opaque_tid(), lane = tid & 63, wave = tid >> 6, fr = lane & 15, q4 = lane >> 4;
    const int t0 = c * 64, h = g * 8 + wave;
    const bf16_t* proj = (const bf16_t*)(a.ws + WS_PROJ);
    const bf16_t* xact = (const bf16_t*)(a.ws + WS_XACT);
    LAS unsigned char* CS = lds;
    LAS unsigned char* BS = lds + 64 * TS * 2;
    LAS unsigned char* XS = lds + 2 * 64 * TS * 2;
    LAS float* GS = (LAS float*)(lds + 2 * 64 * TS * 2 + 64 * XS_STR * 2);
    LAS float* DTS = GS + 64 * 68;
    LAS float* ACS = DTS + 512;
    LAS float* SSQ = ACS + 512;
    const bf16_t* prev = (const bf16_t*)(a.ws + WS_STATES) + ((size_t)(c * NH + h) * 64) * 128;
    bf16x8 pf[4][4];
#pragma unroll
    for (int ks = 0; ks < 4; ++ks)
#pragma unroll
        for (int pb = 0; pb < 4; ++pb) pf[ks][pb] = *(const bf16x8*)(prev + (size_t)(pb * 16 + fr) * 128 + ks * 32 + q4 * 8);
    u32x2 zr[4][4];
#pragma unroll
    for (int lb = 0; lb < 4; ++lb)
#pragma unroll
        for (int pb = 0; pb < 4; ++pb) zr[lb][pb] = *(const u32x2*)(proj + (size_t)(t0 + lb * 16 + fr) * NPROJ + ZOFF + h * 64 + pb * 16 + 4 * q4);
    {
        float dtv, ac;
        head_dt((const float*)(a.ws + WS_DTRAW), a.dt_bias + layer * NH, a.a_log + layer * NH, t0, h, lane, dtv, ac);
        DTS[wave * 64 + lane] = dtv; ACS[wave * 64 + lane] = ac;
    }
    {
        u32x4 xv[8], bv[2], cv[2];
#pragma unroll
        for (int i = 0; i < 8; ++i) { const int piece = tid + 512 * i, row = piece >> 6, ch = piece & 63; xv[i] = *(const u32x4*)(xact + (size_t)(t0 + row) * CONVD + g * 512 + ch * 8); }
#pragma unroll
        for (int i = 0; i < 2; ++i) { const int piece = tid + 512 * i, row = piece >> 4, ch = piece & 15;
            bv[i] = *(const u32x4*)(xact + (size_t)(t0 + row) * CONVD + 2048 + g * 128 + ch * 8); cv[i] = *(const u32x4*)(xact + (size_t)(t0 + row) * CONVD + 2560 + g * 128 + ch * 8); }
#pragma unroll
        for (int i = 0; i < 8; ++i) { const int piece = tid + 512 * i, row = piece >> 6, ch = piece & 63; *(LAS u32x4*)(XS + (row * XS_STR + ch * 8) * 2) = xv[i]; }
#pragma unroll
        for (int i = 0; i < 2; ++i) { const int piece = tid + 512 * i, row = piece >> 4, ch = piece & 15;
            *(LAS u32x4*)(BS + (row * TS + ch * 8) * 2) = bv[i]; *(LAS u32x4*)(CS + (row * TS + ch * 8) * 2) = cv[i]; }
    }
    __syncthreads();
    {
        const int lb = wave >> 1;
#pragma unroll
        for (int sj = 0; sj < 2; ++sj) {
            const int sb = 2 * (wave & 1) + sj;
            f32x4 gacc = {0.f, 0.f, 0.f, 0.f};
#pragma unroll
            for (int ks = 0; ks < 4; ++ks) {
                const bf16x8 cf = *(const LAS bf16x8*)(CS + ((lb * 16 + fr) * TS + ks * 32 + q4 * 8) * 2);
                const bf16x8 bfr = *(const LAS bf16x8*)(BS + ((sb * 16 + fr) * TS + ks * 32 + q4 * 8) * 2);
                gacc = mfma16(cf, bfr, gacc);
            }
#pragma unroll
            for (int r = 0; r < 4; ++r) GS[(lb * 16 + 4 * q4 + r) * 68 + sb * 16 + fr] = gacc[r];
        }
    }
    __syncthreads();
    f32x4 acc[4][4];
#pragma unroll
    for (int pb = 0; pb < 4; ++pb)
#pragma unroll
        for (int lb = 0; lb < 4; ++lb) acc[pb][lb] = (f32x4){0.f, 0.f, 0.f, 0.f};
#pragma unroll
    for (int ks = 0; ks < 4; ++ks) {
        bf16x8 cf[4];
#pragma unroll
        for (int lb = 0; lb < 4; ++lb) cf[lb] = *(const LAS bf16x8*)(CS + ((lb * 16 + fr) * TS + ks * 32 + q4 * 8) * 2);
#pragma unroll
        for (int pb = 0; pb < 4; ++pb)
#pragma unroll
            for (int lb = 0; lb < 4; ++lb) acc[pb][lb] = mfma16(pf[ks][pb], cf[lb], acc[pb][lb]);
    }
    float acl[4];
#pragma unroll
    for (int lb = 0; lb < 4; ++lb) {
        acl[lb] = ACS[wave * 64 + lb * 16 + fr];
        const float el = __expf(acl[lb]);
#pragma unroll
        for (int pb = 0; pb < 4; ++pb) acc[pb][lb] *= el;
    }
    const float Dh = a.d_skip[layer * NH + h];
#pragma unroll
    for (int ks2 = 0; ks2 < 2; ++ks2) {
        float as8[8], ds8[8];
        {
            const f32x4 a0 = *(const LAS f32x4*)(ACS + wave * 64 + ks2 * 32 + q4 * 8), a1 = *(const LAS f32x4*)(ACS + wave * 64 + ks2 * 32 + q4 * 8 + 4);
            const f32x4 d0 = *(const LAS f32x4*)(DTS + wave * 64 + ks2 * 32 + q4 * 8), d1 = *(const LAS f32x4*)(DTS + wave * 64 + ks2 * 32 + q4 * 8 + 4);
#pragma unroll
            for (int j = 0; j < 4; ++j) { as8[j] = a0[j]; as8[4 + j] = a1[j]; ds8[j] = d0[j]; ds8[4 + j] = d1[j]; }
        }
        bf16x8 xf[4];
#pragma unroll
        for (int pb = 0; pb < 4; ++pb) xf[pb] = tr_frag(XS, XS_STR, ks2 * 32 + q4 * 8, wave * 64 + pb * 16, fr);
#pragma unroll
        for (int lb = 0; lb < 4; ++lb) {
            if (ks2 * 32 > lb * 16 + 15) continue;
            const int l = lb * 16 + fr;
            const f32x4 g0 = *(const LAS f32x4*)(GS + l * 68 + ks2 * 32 + q4 * 8), g1 = *(const LAS f32x4*)(GS + l * 68 + ks2 * 32 + q4 * 8 + 4);
            float mv[8];
#pragma unroll
            for (int j = 0; j < 8; ++j) {
                const int s_ = ks2 * 32 + q4 * 8 + j;
                const float gv = (j < 4) ? g0[j & 3] : g1[j & 3];
                float v = (s_ <= l) ? gv * __expf(acl[lb] - as8[j]) * ds8[j] : 0.f;
                if (s_ == l) v += Dh;
                mv[j] = v;
            }
            u32x4 mp; mp.x = pk2(mv[0], mv[1]); mp.y = pk2(mv[2], mv[3]); mp.z = pk2(mv[4], mv[5]); mp.w = pk2(mv[6], mv[7]);
            const bf16x8 mf = __builtin_bit_cast(bf16x8, mp);
#pragma unroll
            for (int pb = 0; pb < 4; ++pb) acc[pb][lb] = mfma16(xf[pb], mf, acc[pb][lb]);
        }
    }
#pragma unroll
    for (int lb = 0; lb < 4; ++lb) {
        const int l = lb * 16 + fr; float ss = 0.f;
#pragma unroll
        for (int pb = 0; pb < 4; ++pb) {
            const u32x2 z2 = zr[lb][pb];
            f32x4 y = acc[pb][lb];
            y[0] *= silu_f(bf_lo(z2.x)); y[1] *= silu_f(bf_hi(z2.x)); y[2] *= silu_f(bf_lo(z2.y)); y[3] *= silu_f(bf_hi(z2.y));
            acc[pb][lb] = y;
            ss += (y[0] * y[0] + y[1] * y[1]) + (y[2] * y[2] + y[3] * y[3]);
        }
        ss += __shfl_xor(ss, 16); ss += __shfl_xor(ss, 32);
        if (q4 == 0) SSQ[wave * 64 + l] = ss;
    }
    __syncthreads();
    bf16_t* mix = (bf16_t*)(a.ws + WS_MIX);
    const float* nw = a.ssd_norm_w + (size_t)layer * 2048 + h * 64;
    f32x4 wv[4];
#pragma unroll
    for (int pb = 0; pb < 4; ++pb) wv[pb] = *(const f32x4*)(nw + pb * 16 + 4 * q4);
#pragma unroll
    for (int lb = 0; lb < 4; ++lb) {
        const int l = lb * 16 + fr; float tot = 0.f;
#pragma unroll
        for (int w2 = 0; w2 < 8; ++w2) tot += SSQ[w2 * 64 + l];
        const float rs = rsqrtf(tot * (1.0f / 512.0f) + EPS);
#pragma unroll
        for (int pb = 0; pb < 4; ++pb) {
            const f32x4 y = acc[pb][lb];
            u32x2 o; o.x = pk2(y[0] * rs * wv[pb][0], y[1] * rs * wv[pb][1]); o.y = pk2(y[2] * rs * wv[pb][2], y[3] * rs * wv[pb][3]);
            *(u32x2*)(mix + (size_t)(t0 + l) * DMIX + h * 64 + pb * 16 + 4 * q4) = o;
        }
    }
    __syncthreads();
}

typedef float f32x2 __attribute__((ext_vector_type(2)));
template <bool MASK> DI void sb_block(const f32x4& zacc, float scale2, int s0, int t, float m1, float m2, float& R, unsigned& w0, unsigned& w1) {
    const f32x2 za = (f32x2){zacc[0], zacc[1]} * scale2, zb = (f32x2){zacc[2], zacc[3]} * scale2;
    f32x2 ea, eb;
    ea.x = __builtin_amdgcn_exp2f(-fabsf(za.x)); ea.y = __builtin_amdgcn_exp2f(-fabsf(za.y)); eb.x = __builtin_amdgcn_exp2f(-fabsf(zb.x)); eb.y = __builtin_amdgcn_exp2f(-fabsf(zb.y));
    const f32x2 ua = ea + 1.0f, ub = eb + 1.0f;
    f32x2 la, lb, ma, mb;
    la.x = __builtin_amdgcn_logf(ua.x); la.y = __builtin_amdgcn_logf(ua.y); lb.x = __builtin_amdgcn_logf(ub.x); lb.y = __builtin_amdgcn_logf(ub.y);
    ma.x = fmaxf(za.x, 0.f); ma.y = fmaxf(za.y, 0.f); mb.x = fmaxf(zb.x, 0.f); mb.y = fmaxf(zb.y, 0.f);
    f32x2 spa = ma + la, spb = mb + lb;
    bool v0 = true, v1 = true, v2 = true, v3 = true;
    if (MASK) { v0 = s0 < t; v1 = s0 + 1 < t; v2 = s0 + 2 < t; v3 = s0 + 3 < t;
        spa.x = v0 ? spa.x : 0.f; spa.y = v1 ? spa.y : 0.f; spb.x = v2 ? spb.x : 0.f; spb.y = v3 ? spb.y : 0.f; }
    const float suf3 = spb.y, suf2 = spb.x + suf3, suf1 = spa.y + suf2, suf0 = spa.x + suf1;
    const auto s16 = __builtin_amdgcn_permlane16_swap(__float_as_uint(suf0), __float_as_uint(suf0), false, false);
    const float po = __uint_as_float(s16[1]);
    const float psum = __uint_as_float(s16[0]) + po;
    const auto s32 = __builtin_amdgcn_permlane32_swap(__float_as_uint(psum), __float_as_uint(psum), false, false);
    const float hlo = __uint_as_float(s32[0]), hhi = __uint_as_float(s32[1]);
    const float nb = -(R + (m1 * po + m2 * hhi));
    R += hlo + hhi;
    const f32x2 aa = (za + nb) - (f32x2){suf0, suf1}, ab = (zb + nb) - (f32x2){suf2, suf3};
    float x0 = __builtin_amdgcn_exp2f(aa.x), x1 = __builtin_amdgcn_exp2f(aa.y), x2 = __builtin_amdgcn_exp2f(ab.x), x3 = __builtin_amdgcn_exp2f(ab.y);
    if (MASK) { x0 = v0 ? x0 : 0.f; x1 = v1 ? x1 : 0.f; x2 = v2 ? x2 : 0.f; x3 = v3 ? x3 : 0.f; }
    w0 = pk2(x0, x1); w1 = pk2(x2, x3);
}

constexpr int NTB = 1, ATT_Q = 128 * NTB;
DI void attn_unit(const Args& a, int h, int qb, LAS unsigned char* lds) {
    const int tid = opaque_tid(), lane = tid & 63, wave = tid >> 6, fr = lane & 15, q4 = lane >> 4;
    const bf16_t* proj = (const bf16_t*)(a.ws + WS_PROJ);
    constexpr int KVB = 64 * TS * 2;
    LAS int* FLG = (LAS int*)(lds + 4 * KVB);
    const int q0 = qb * ATT_Q, tq0 = q0 + wave * 16 * NTB, tmax = tq0 + 16 * NTB - 2;
    const float scale2 = 0.08838834764831845f * 1.4426950408889634f;
    constexpr float THR2 = 151.0f;
    bf16x8 qf[NTB][4];
#pragma unroll
    for (int tb = 0; tb < NTB; ++tb)
#pragma unroll
        for (int ks = 0; ks < 4; ++ks) qf[tb][ks] = *(const bf16x8*)(proj + (size_t)(tq0 + tb * 16 + fr) * NPROJ + QOFF + h * 128 + ks * 32 + q4 * 8);
    f32x4 oacc[NTB][8];
    u32x2 gpre[NTB][8];
#pragma unroll
    for (int tb = 0; tb < NTB; ++tb)
#pragma unroll
        for (int db = 0; db < 8; ++db) {
            oacc[tb][db] = (f32x4){0.f, 0.f, 0.f, 0.f};
            gpre[tb][db] = *(const u32x2*)(proj + (size_t)(tq0 + tb * 16 + fr) * NPROJ + GOFF + h * 128 + db * 16 + 4 * q4);
        }
    float R[NTB];
#pragma unroll
    for (int tb = 0; tb < NTB; ++tb) R[tb] = 0.f;
    const float m1 = (q4 & 1) ? 0.f : 1.f, m2 = (q4 < 2) ? 1.f : 0.f;
    bool fin = false;
    int b = 0;
    const int kt_top = (q0 + ATT_Q - 1) >> 6;
    u32x4 kreg[2], vreg[2];
    const int prow = tid >> 4, pch = tid & 15;
    {
        const bf16_t* src = proj + (size_t)(kt_top * 64 + prow) * NPROJ + h * 128 + pch * 8;
        kreg[0] = *(const u32x4*)(src + KOFF); vreg[0] = *(const u32x4*)(src + VOFF);
        kreg[1] = *(const u32x4*)(src + (size_t)32 * NPROJ + KOFF); vreg[1] = *(const u32x4*)(src + (size_t)32 * NPROJ + VOFF);
    }
    for (int kt = kt_top; kt >= 0; --kt) {
        const int k0 = kt * 64;
        LAS unsigned char* KS = lds + b * 2 * KVB; LAS unsigned char* VS = KS + KVB;
        *(LAS u32x4*)(KS + (prow * TS + pch * 8) * 2) = kreg[0]; *(LAS u32x4*)(KS + ((prow + 32) * TS + pch * 8) * 2) = kreg[1];
        *(LAS u32x4*)(VS + (prow * TS + pch * 8) * 2) = vreg[0]; *(LAS u32x4*)(VS + ((prow + 32) * TS + pch * 8) * 2) = vreg[1];
        if (lane == 0) FLG[b * 8 + wave] = fin ? 1 : 0;
        __syncthreads();
        int allfin = 1;
#pragma unroll
        for (int w2 = 0; w2 < 8; ++w2) allfin &= FLG[b * 8 + w2];
        if (allfin) break;
        if (kt > 0) {
            const bf16_t* src = proj + (size_t)(k0 - 64 + prow) * NPROJ + h * 128 + pch * 8;
            kreg[0] = *(const u32x4*)(src + KOFF); vreg[0] = *(const u32x4*)(src + VOFF);
            kreg[1] = *(const u32x4*)(src + (size_t)32 * NPROJ + KOFF); vreg[1] = *(const u32x4*)(src + (size_t)32 * NPROJ + VOFF);
        }
        if (!fin && k0 <= tmax) {
#pragma unroll
            for (int kk = 1; kk >= 0; --kk) {
                u32x4 wp[NTB];
#pragma unroll
                for (int tb = 0; tb < NTB; ++tb) wp[tb] = (u32x4){0u, 0u, 0u, 0u};
                bool any = false;
#pragma unroll
                for (int half = 1; half >= 0; --half) {
                    const int kb = 2 * kk + half, kbase = k0 + 16 * kb;
                    if (fin || kbase > tmax) continue;
                    any = true;
                    f32x4 z[NTB];
#pragma unroll
                    for (int tb = 0; tb < NTB; ++tb) z[tb] = (f32x4){0.f, 0.f, 0.f, 0.f};
#pragma unroll
                    for (int ks = 0; ks < 4; ++ks) {
                        const bf16x8 kf = *(const LAS bf16x8*)(KS + ((kb * 16 + fr) * TS + ks * 32 + q4 * 8) * 2);
#pragma unroll
                        for (int tb = 0; tb < NTB; ++tb) z[tb] = mfma16(kf, qf[tb][ks], z[tb]);
                    }
                    bool ok = true;
#pragma unroll
                    for (int tb = 0; tb < NTB; ++tb) {
                        const int t = tq0 + tb * 16 + fr;
                        unsigned w0, w1;
                        sb_block<true>(z[tb], scale2, kbase + 4 * q4, t, m1, m2, R[tb], w0, w1);
                        if (half == 0) { wp[tb].x = w0; wp[tb].y = w1; } else { wp[tb].z = w0; wp[tb].w = w1; }
                        ok = ok && (R[tb] >= THR2);
                    }
                    fin = __all(ok);
                }
                if (any) {
#pragma unroll
                    for (int db = 0; db < 8; ++db) {
                        LAS unsigned char* vp = VS + ((kk * 32 + 4 * q4 + (fr >> 2)) * TS + db * 16 + 4 * (fr & 3)) * 2;
                        const s16x4 lo = __builtin_amdgcn_ds_read_tr16_b64_v4i16((LAS s16x4*)vp);
                        const s16x4 hi = __builtin_amdgcn_ds_read_tr16_b64_v4i16((LAS s16x4*)(vp + 16 * TS * 2));
                        bf16x8 vf; vf[0] = lo[0]; vf[1] = lo[1]; vf[2] = lo[2]; vf[3] = lo[3]; vf[4] = hi[0]; vf[5] = hi[1]; vf[6] = hi[2]; vf[7] = hi[3];
#pragma unroll
                        for (int tb = 0; tb < NTB; ++tb) oacc[tb][db] = mfma16(vf, __builtin_bit_cast(bf16x8, wp[tb]), oacc[tb][db]);
                    }
                }
            }
        }
        b ^= 1;
    }
    bf16_t* mix = (bf16_t*)(a.ws + WS_MIX);
#pragma unroll
    for (int tb = 0; tb < NTB; ++tb) {
        const int t = tq0 + tb * 16 + fr;
#pragma unroll
        for (int db = 0; db < 8; ++db) {
            const u32x2 gr = gpre[tb][db];
            const f32x4 o = oacc[tb][db];
            u32x2 ov; ov.x = pk2(o[0] * silu_f(bf_lo(gr.x)), o[1] * silu_f(bf_hi(gr.x))); ov.y = pk2(o[2] * silu_f(bf_lo(gr.y)), o[3] * silu_f(bf_hi(gr.y)));
            *(u32x2*)(mix + (size_t)t * DMIX + 2048 + h * 128 + db * 16 + 4 * q4) = ov;
        }
    }
    __syncthreads();
}

DI void phase_final(const Args& a) {
    const int tid = opaque_tid(), lane = tid & 63, wave = tid >> 6;
    const int gw = blockIdx.x * 8 + wave, NGW = gridDim.x * 8;
    const bf16_t* xb = (const bf16_t*)(a.ws + WS_XB); const float* ssp = (const float*)(a.ws + WS_SSP);
    for (int row = gw; row < S; row += NGW) {
        const float rs = row_rstd(ssp, row);
        const u32x2* xr = (const u32x2*)(xb + (size_t)row * DM) + lane;
        const f32x4* wr = (const f32x4*)a.final_norm_w + lane;
        f32x4* orow = (f32x4*)(a.out + (size_t)row * DM) + lane;
#pragma unroll
        for (int j = 0; j < 8; ++j) {
            const u32x2 xv = xr[64 * j]; const f32x4 w = wr[64 * j];
            f32x4 o; o[0] = bf_lo(xv.x) * rs * w[0]; o[1] = bf_hi(xv.x) * rs * w[1]; o[2] = bf_lo(xv.y) * rs * w[2]; o[3] = bf_hi(xv.y) * rs * w[3];
            orow[64 * j] = o;
        }
    }
}

__global__ void __launch_bounds__(512, 2) hybrid_fwd(Args a) {
    extern __shared__ __attribute__((aligned(16))) unsigned char lds_raw[];
    LAS unsigned char* lds = (LAS unsigned char*)lds_raw;
    const int G = gridDim.x, bx = blockIdx.x;
    volatile LAS unsigned* bst = (volatile LAS unsigned*)(lds + LDS_BYTES - 16);
    if (threadIdx.x < 4) bst[threadIdx.x] = 0u;
    __syncthreads();
    if (bx == 0) for (int i = threadIdx.x; i < 4096; i += 512) ((unsigned*)(a.ws + WS_BAR))[i] = 0u;
    XcdBarrier bar; bar.bar = (unsigned*)(a.ws + WS_BAR); bar.x = xb_xcc_id(); bar.st = bst;
    int vb = bx;
    int rep = 0;
    for (int ph = a.ph_lo; ph < a.ph_hi;) {
        int ptype;
        if (ph == 0) ptype = 1; else if (ph == NPHASE - 1) ptype = 512; else { const int sub = (ph - 1) % 5; ptype = sub == 0 ? 2 : sub == 1 ? (8 | 16) : sub == 2 ? 32 : sub == 3 ? 64 : 128; }
        const bool dummy = (DUPM & ptype) && rep == 0;
        if (ph == 0) {
#if !(SKIPM & 1)
            phase_prologue(a, lds);
#endif
        } else if (ph == NPHASE - 1) {
            phase_final(a);
        } else {
            const int layer = (ph - 1) / 5, sub = (ph - 1) % 5;
            if (sub == 0) {
                pg8::Gemm g; g.A = (const bf16_t*)(a.ws + WS_XB); g.Bt = (const bf16_t*)(a.ws + WS_WIN) + (size_t)layer * NPROJ * DM; g.M = S; g.N = NPROJ; g.K = DM;
                pg8::StaticOrder so; so.init(S, NPROJ, G, vb);
                pg8::EpiInProj e; e.O = (bf16_t*)(a.ws + WS_PROJ); e.ssp = (const float*)(a.ws + WS_SSP);
                {
                    pg8::Unit u0; u0.pm = 0; u0.pn = 0; so.next(0, u0);
                    LAS float* rsl = (LAS float*)(lds + pg8::STAGE_BYTES);
                    const int t_ = opaque_tid();
                    if (t_ < 256) rsl[t_] = row_rstd(e.ssp, u0.pm * 256 + t_);
                    e.rs_lds = rsl; e.pm0 = u0.pm;
                    __syncthreads();
                }
#if !(SKIPM & 2)
                pg8::gemm_phase(lds, g, so, e);
#endif
                const int nfull = (S / 256) * (NPROJ / 256);
                const int rem = nfull % G;
                const int wave = opaque_tid() >> 6;
#if !(SKIPM & 4)
                if (rem == 0 || G - rem < 64) dt_gemm(a, layer, vb, G, lds);
                else if (vb >= rem) dt_gemm(a, layer, vb - rem, G - rem, lds);
#endif
                if (layer + 1 < NL && !dummy) {
                    const int lane = opaque_tid() & 63;
                    LAS float* scr = (LAS float*)(lds + wave * 16896);
                    if (rem == 0 || G - rem < 64) { for (int it = CV_PER_L - CV_SLOT + vb * 8 + wave; it < CV_PER_L; it += G * 8) convert_item(a, layer + 1, it, scr, lane); }
                    else if (vb >= rem) { for (int it = CV_PER_L - CV_SLOT + (vb - rem) * 8 + wave; it < CV_PER_L; it += (G - rem) * 8) convert_item(a, layer + 1, it, scr, lane); }
                }
            } else if (sub == 1) {
#if !(SKIPM & 8)
                if (!(DUPM & 24) || !dummy || (DUPM & 8))
                for (int u = bx; u < 512; u += G) ssd_states_unit(a, layer, u >> 2, u & 3, lds);
#endif
            } else if (sub == 2) {
#if !(SKIPM & 32)
                phase_scan(a, a.ws + (dummy ? WS_END : WS_STATES));
#endif
            } else if (sub == 3) {
#if !(SKIPM & 64)
                for (int u = bx; u < 512; u += G) ssd_out_unit(a, layer, u >> 2, u & 3, lds);
#endif
                for (int u = bx; u < 16 * (S / ATT_Q); u += G) attn_unit(a, u & 15, u >> 4, lds);
            } else {
                pg8::Gemm g; g.A = (const bf16_t*)(a.ws + WS_MIX); g.Bt = (const bf16_t*)(a.ws + WS_WOUT) + (size_t)layer * DM * DMIX; g.M = S; g.N = DM; g.K = DMIX;
                pg8::StaticOrder so; so.init(S, DM, G, vb);
                pg8::EpiOutProj e; e.xb = (bf16_t*)(a.ws + WS_XB); e.ssp = (float*)(a.ws + WS_SSP);
#if !(SKIPM & 128)
                pg8::gemm_phase(lds, g, so, e);
#endif
            }
        }
        if (dummy) rep = 1; else { rep = 0; ++ph; }
        if (ph < a.ph_hi) {
            if (ph == 1 && !dummy) {
                cg::this_grid().sync();
                if (threadIdx.x == 0) (void)xb_add(&bar.bar[XB_XCNT(bar.x)], 1u);
            } else xcd_barrier(bar);
        }
    }
#if (DUPM & 256)
    for (int i = 0; i < 20; ++i) cg::this_grid().sync();
#endif
}

extern "C" void kernel_launch(void* const* d_in, const int* in_sizes, int n_in, void* d_out, int out_size, void* d_ws, size_t ws_size, hipStream_t stream) {
    static int grid = 0;
    if (grid == 0) {
        if (n_in != 11 || out_size != S * DM || ws_size < WS_END) { fprintf(stderr, "kernel_launch: unexpected shapes (n_in %d out %d ws %zu need %zu)\n", n_in, out_size, ws_size, (size_t)WS_END); grid = -1; return; }
        int dev = 0, cus = 0, per_cu = 0;
        hipGetDevice(&dev);
        hipDeviceGetAttribute(&cus, hipDeviceAttributeMultiprocessorCount, dev);
        if (hipFuncSetAttribute((const void*)hybrid_fwd, hipFuncAttributeMaxDynamicSharedMemorySize, LDS_BYTES) != hipSuccess) { fprintf(stderr, "kernel_launch: hipFuncSetAttribute failed\n"); grid = -1; return; }
        hipOccupancyMaxActiveBlocksPerMultiprocessor(&per_cu, (const void*)hybrid_fwd, 512, LDS_BYTES);
        (void)hipGetLastError();
        if (per_cu < 1) { fprintf(stderr, "kernel_launch: occupancy query says %d blocks per CU\n", per_cu); per_cu = 1; }
        grid = cus;
        if (grid != 256) fprintf(stderr, "kernel_launch: %d CUs; this build assumes 256\n", grid);
    }
    if (grid < 0) return;
    Args a{};
    a.x = (const float*)d_in[0]; a.norm_w = (const float*)d_in[1]; a.w_in = (const float*)d_in[2]; a.conv_w = (const float*)d_in[3]; a.conv_b = (const float*)d_in[4];
    a.dt_bias = (const float*)d_in[5]; a.a_log = (const float*)d_in[6]; a.d_skip = (const float*)d_in[7]; a.ssd_norm_w = (const float*)d_in[8];
    a.w_out = (const float*)d_in[9]; a.final_norm_w = (const float*)d_in[10];
    a.out = (float*)d_out; a.ws = (unsigned char*)d_ws;
#if ONE_LAUNCH
    a.ph_lo = 0; a.ph_hi = NPHASE;
    void* args[] = {&a};
    hipError_t e = hipLaunchCooperativeKernel((const void*)hybrid_fwd, dim3(grid), dim3(512), args, LDS_BYTES, stream);
    if (e != hipSuccess) fprintf(stderr, "cooperative launch failed: %s (grid %d)\n", hipGetErrorString(e), grid);
#else
    for (int ph = 0; ph < NPHASE; ++ph) {
        a.ph_lo = ph; a.ph_hi = ph + 1;
        hipLaunchKernelGGL(hybrid_fwd, dim3(grid), dim3(512), LDS_BYTES, stream, a);
    }
#endif
}
```

```cpp
#include <hip/hip_runtime.h>
#include <hip/hip_cooperative_groups.h>
#include <cstdio>
#include <cstdint>
namespace cg = cooperative_groups;

#ifndef DUPM
#define DUPM 0
#endif
#ifndef SKIPM
#define SKIPM 0
#endif
#ifndef ONE_LAUNCH
#define ONE_LAUNCH 1
#endif

#define LAS __attribute__((address_space(3)))
#define DI __device__ __forceinline__
typedef unsigned short bf16_t;
typedef short bf16x8 __attribute__((ext_vector_type(8)));
typedef float f32x4 __attribute__((ext_vector_type(4)));
typedef unsigned u32x4 __attribute__((ext_vector_type(4)));
typedef unsigned u32x2 __attribute__((ext_vector_type(2)));

constexpr int S = 8192, DM = 2048, NL = 4, NPROJ = 13312, INCOLS = 13344, DMIX = 4096;
constexpr int ZOFF = 0, XOFF = 2048, BOFF = 4096, COFF = 4608, QOFF = 5120, KOFF = 7168, VOFF = 9216, GOFF = 11264;
constexpr int NCHUNK = 128, NH = 32, CONVD = 3072;
constexpr float EPS = 1e-6f;
constexpr int LDS_BYTES = 147456;
constexpr int NPHASE = 2 + 5 * NL;

constexpr size_t WS_WIN = 0;
constexpr size_t WS_WDT = WS_WIN + (size_t)NL * NPROJ * DM * 2;
constexpr size_t WS_WOUT = WS_WDT + (size_t)NL * 32 * DM * 2;
constexpr size_t WS_XB = WS_WOUT + (size_t)NL * DM * DMIX * 2;
constexpr size_t WS_XRES = WS_XB + (size_t)S * DM * 2;
constexpr size_t WS_PROJ = WS_XRES + (size_t)S * DM * 4;
constexpr size_t WS_DTRAW = WS_PROJ + (size_t)S * NPROJ * 2;
constexpr size_t WS_MIX = WS_DTRAW + (size_t)S * 32 * 4;
constexpr size_t WS_STATES = WS_MIX + (size_t)S * DMIX * 2;
constexpr size_t WS_CDEC = WS_STATES + (size_t)NCHUNK * NH * 64 * 128 * 2;
constexpr size_t WS_SSP = WS_CDEC + (size_t)NCHUNK * NH * 4;
constexpr size_t WS_XACT = WS_SSP + (size_t)8 * S * 4;
constexpr size_t WS_BAR = WS_XACT + (size_t)S * CONVD * 2;
constexpr size_t WS_END = WS_BAR + 16384;

DI unsigned pk2(float lo, float hi) { unsigned r; asm volatile("v_cvt_pk_bf16_f32 %0, %1, %2" : "=v"(r) : "v"(lo), "v"(hi)); return r; }
DI int opaque_tid() { int t = threadIdx.x; asm volatile("" : "+v"(t)); return t; }
DI float bf_lo(unsigned w) { return __uint_as_float(w << 16); }
DI float bf_hi(unsigned w) { return __uint_as_float(w & 0xffff0000u); }
DI float silu_f(float x) { return x * __builtin_amdgcn_rcpf(1.0f + __expf(-x)); }
DI f32x4 mfma16(bf16x8 a, bf16x8 b, f32x4 c) { return __builtin_amdgcn_mfma_f32_16x16x32_bf16(a, b, c, 0, 0, 0); }
typedef short s16x4 __attribute__((ext_vector_type(4)));
DI bf16x8 tr_frag(LAS unsigned char* base, int stride_el, int row0, int col0, int fr) {
    const int q = fr >> 2, p_ = fr & 3;
    LAS unsigned char* p0 = base + ((row0 + q) * stride_el + col0 + 4 * p_) * 2;
    const s16x4 lo = __builtin_amdgcn_ds_read_tr16_b64_v4i16((LAS s16x4*)p0);
    const s16x4 hi = __builtin_amdgcn_ds_read_tr16_b64_v4i16((LAS s16x4*)(p0 + 8 * stride_el));
    bf16x8 r; r[0] = lo[0]; r[1] = lo[1]; r[2] = lo[2]; r[3] = lo[3]; r[4] = hi[0]; r[5] = hi[1]; r[6] = hi[2]; r[7] = hi[3];
    return r;
}
DI float row_rstd(const float* ssp, int row) {
    float s = 0.f;
#pragma unroll
    for (int j = 0; j < 8; ++j) s += ssp[j * S + row];
    return rsqrtf(s * (1.0f / DM) + EPS);
}

namespace pg8 {
constexpr int BM = 256, BK = 64, HALF = 128, HTB = HALF * BK * 2, STAGE_BYTES = 8 * HTB, NXCD = 8, WGM = 8;
DI int lds_byte(int r, int c) { const int st = (r >> 4) * 2 + (c >> 5), rr = r & 15, cc = c & 31, ob = rr * 64 + cc * 2; return st * 1024 + (ob ^ (((ob >> 9) & 1) << 5)); }
DI void stage_rc(int b, int& R, int& C) { const int st = b / 1024, sb = b % 1024, swz = sb ^ (((sb >> 9) & 1) << 5); R = (st >> 1) * 16 + swz / 64; C = (st & 1) * 32 + (swz % 64) / 2; }
DI int perm32(int rho) { const int n = rho >> 4, i = rho & 15; return 8 * (i >> 2) + 4 * n + (i & 3); }
struct Unit { int pm, pn; };
struct Gemm { const bf16_t* A; const bf16_t* Bt; int M, N, K; };
struct StaticOrder {
    int nM, nN, nwg, G, c;
    DI void init(int M, int N, int G_, int c_) { nM = M / BM; nN = N / BM; nwg = nM * nN; G = G_; c = c_; }
    DI bool next(int i, Unit& u) const {
        const long L = (long)i * G + c; if (L >= nwg) return false;
        int wgid = (int)L; { const int q = nwg / NXCD, r = nwg % NXCD, xcd = wgid % NXCD, off = wgid / NXCD; wgid = (xcd < r ? xcd * (q + 1) : r * (q + 1) + (xcd - r) * q) + off; }
        const int nig = WGM * nN, gid = wgid / nig, fm = gid * WGM, gsz = (nM - fm) < WGM ? (nM - fm) : WGM;
        u.pm = fm + ((wgid % nig) % gsz); u.pn = (wgid % nig) / gsz; return true;
    }
};

template <class Epi>
DI void gemm_phase(LAS unsigned char* lds, const Gemm g, const StaticOrder& S_, const Epi& E) {
    const int tid = opaque_tid(), wid = __builtin_amdgcn_readfirstlane(tid >> 6), lane = tid & 63, wr = wid >> 2, wc = wid & 3, fr = lane & 15, fq = lane >> 4;
    const int K = g.K, nt = K / BK;
    unsigned voffA[2], voffB[2];
#pragma unroll
    for (int i = 0; i < 2; ++i) { int R, C; stage_rc(tid * 16 + i * 8192, R, C); const int Rb = Epi::PERM ? ((R & ~31) + perm32(R & 31)) : R;
        voffA[i] = (unsigned)(R * K + C) * 2u; voffB[i] = (unsigned)(Rb * K + C) * 2u; }
    const size_t kstep = (size_t)(BK * 2);
    const size_t hstep = (size_t)HALF * K * 2;
    const size_t tstep = 2 * hstep;
    const unsigned ldsw = (unsigned)wid * 1024u;
    const int aoff = lds_byte(wr * 64 + fr, fq * 8), boff = lds_byte(wc * 32 + fr, fq * 8);
#define PG8_SA(b, h) (((b) * 2 + (h)) * HTB)
#define PG8_SB(b, h) ((4 + (b) * 2 + (h)) * HTB)
#define PG8_STAGE(bufoff, gbase, voff) do { _Pragma("unroll") for (int _i = 0; _i < 2; ++_i) \
        __builtin_amdgcn_global_load_lds((const unsigned*)((const char*)(gbase) + (voff)[_i]), (LAS unsigned*)(lds + (bufoff) + ldsw + _i * 8192), 16, 0, 0); } while (0)
#define PG8_LDA(dst, b, h) do { _Pragma("unroll") for (int m = 0; m < 4; ++m) _Pragma("unroll") for (int k = 0; k < 2; ++k) dst[m][k] = *(const LAS bf16x8*)(lds + PG8_SA(b, h) + aoff + m * 2048 + k * 1024); } while (0)
#define PG8_LDB(dst, b, h) do { _Pragma("unroll") for (int n = 0; n < 2; ++n) _Pragma("unroll") for (int k = 0; k < 2; ++k) dst[n][k] = *(const LAS bf16x8*)(lds + PG8_SB(b, h) + boff + n * 2048 + k * 1024); } while (0)
#define PG8_MMA(ai, bj, At, Bt) do { __builtin_amdgcn_s_setprio(1); _Pragma("unroll") for (int m = 0; m < 4; ++m) _Pragma("unroll") for (int n = 0; n < 2; ++n) _Pragma("unroll") for (int k = 0; k < 2; ++k) \
        acc[ai][bj][m][n] = __builtin_amdgcn_mfma_f32_16x16x32_bf16(Bt[n][k], At[m][k], acc[ai][bj][m][n], 0, 0, 0); __builtin_amdgcn_s_setprio(0); } while (0)
#define PG8_WAIT_V(n) asm volatile("s_waitcnt vmcnt(" #n ")" ::: "memory")
#define PG8_WAIT_L(n) asm volatile("s_waitcnt lgkmcnt(" #n ")" ::: "memory")
#define PG8_BAR __builtin_amdgcn_s_barrier()
#define PG8_SCHED __builtin_amdgcn_sched_barrier(0)
    Unit cur, nxt; int ui = 0;
    if (!S_.next(0, cur)) return;
    f32x4 acc[2][2][4][2];
#pragma unroll
    for (int a = 0; a < 2; ++a)
#pragma unroll
        for (int b = 0; b < 2; ++b)
#pragma unroll
            for (int m = 0; m < 4; ++m)
#pragma unroll
                for (int n = 0; n < 2; ++n) acc[a][b][m][n] = (f32x4){0.f, 0.f, 0.f, 0.f};
    bf16x8 At[4][2], B0[2][2], B1[2][2];
    const char* cA = (const char*)g.A + (size_t)cur.pm * tstep; const char* cB = (const char*)g.Bt + (size_t)cur.pn * tstep;
    PG8_STAGE(PG8_SB(0, 0), cB, voffB); PG8_STAGE(PG8_SA(0, 0), cA, voffA); PG8_STAGE(PG8_SB(0, 1), cB + hstep, voffB); PG8_STAGE(PG8_SA(0, 1), cA + hstep, voffA);
    if (wr == 1) PG8_BAR;
    PG8_WAIT_V(4); PG8_BAR;
    PG8_STAGE(PG8_SB(1, 0), cB + kstep, voffB); PG8_STAGE(PG8_SA(1, 0), cA + kstep, voffA); PG8_STAGE(PG8_SB(1, 1), cB + hstep + kstep, voffB);
    PG8_WAIT_V(6); PG8_BAR;
    for (;;) {
        const bool has_next = S_.next(ui + 1, nxt);
        const char* nA = has_next ? (const char*)g.A + (size_t)nxt.pm * tstep : cA; const char* nB = has_next ? (const char*)g.Bt + (size_t)nxt.pn * tstep : cB;
        for (int t = 0; t < nt; t += 2) {
            const bool last = (t == nt - 2);
            const char* a1 = cA + (size_t)(t + 1) * kstep;
            const char* a2 = last ? nA : cA + (size_t)(t + 2) * kstep; const char* b2 = last ? nB : cB + (size_t)(t + 2) * kstep;
            const char* a3 = a2 + kstep; const char* b3 = b2 + kstep;
            PG8_LDB(B0, 0, 0); PG8_SCHED; PG8_LDA(At, 0, 0); PG8_STAGE(PG8_SA(1, 1), a1 + hstep, voffA);
            PG8_WAIT_L(8); PG8_BAR; PG8_WAIT_L(0); PG8_MMA(0, 0, At, B0); PG8_BAR; PG8_SCHED;
            PG8_LDB(B1, 0, 1); PG8_STAGE(PG8_SB(0, 0), b2, voffB);
            PG8_BAR; PG8_WAIT_L(0); PG8_MMA(0, 1, At, B1); PG8_BAR;
            PG8_LDA(At, 0, 1); PG8_STAGE(PG8_SA(0, 0), a2, voffA);
            PG8_BAR; PG8_WAIT_L(0); PG8_MMA(1, 0, At, B0); PG8_BAR; PG8_SCHED;
            PG8_STAGE(PG8_SB(0, 1), b2 + hstep, voffB);
            PG8_WAIT_V(6); PG8_BAR; PG8_MMA(1, 1, At, B1); PG8_BAR;
            PG8_LDB(B0, 1, 0); PG8_SCHED; PG8_LDA(At, 1, 0); PG8_STAGE(PG8_SA(0, 1), a2 + hstep, voffA);
            PG8_WAIT_L(8); PG8_BAR; PG8_WAIT_L(0); PG8_MMA(0, 0, At, B0); PG8_BAR; PG8_SCHED;
            PG8_LDB(B1, 1, 1); PG8_STAGE(PG8_SB(1, 0), b3, voffB);
            PG8_BAR; PG8_WAIT_L(0); PG8_MMA(0, 1, At, B1); PG8_BAR;
            PG8_LDA(At, 1, 1); PG8_STAGE(PG8_SA(1, 0), a3, voffA);
            PG8_BAR; PG8_WAIT_L(0); PG8_MMA(1, 0, At, B0); PG8_BAR; PG8_SCHED;
            PG8_STAGE(PG8_SB(1, 1), b3 + hstep, voffB);
            PG8_WAIT_V(6); PG8_BAR; PG8_MMA(1, 1, At, B1); PG8_BAR;
        }
        if constexpr (!Epi::AFTER_DRAIN) { E(acc, cur, wr, wc, fr, fq); }
        if (!has_next) break;
#pragma unroll
        for (int a = 0; a < 2; ++a)
#pragma unroll
            for (int b = 0; b < 2; ++b)
#pragma unroll
                for (int m = 0; m < 4; ++m)
#pragma unroll
                    for (int n = 0; n < 2; ++n) acc[a][b][m][n] = (f32x4){0.f, 0.f, 0.f, 0.f};
        cur = nxt; cA = nA; cB = nB; ++ui;
    }
    PG8_WAIT_V(0);
    if (wr == 0) PG8_BAR;
    PG8_BAR;
    if constexpr (Epi::AFTER_DRAIN) { E.fused(acc, cur, wr, wc, fr, fq, lds, wid, lane); }
#undef PG8_SA
#undef PG8_SB
#undef PG8_STAGE
#undef PG8_LDA
#undef PG8_LDB
#undef PG8_MMA
#undef PG8_WAIT_V
#undef PG8_WAIT_L
#undef PG8_BAR
#undef PG8_SCHED
}

struct EpiInProj {
    static constexpr bool PERM = true, AFTER_DRAIN = false;
    bf16_t* O; const float* ssp; const LAS float* rs_lds; int pm0;
    DI void operator()(const f32x4 (&acc)[2][2][4][2], const Unit& u, int wr, int wc, int fr, int fq) const {
        const int row0 = u.pm * BM + wr * 64 + fr; const int col0 = u.pn * BM + wc * 32 + 8 * fq;
        const bool lds_ok = (u.pm == pm0);
#pragma unroll
        for (int ai = 0; ai < 2; ++ai)
#pragma unroll
            for (int m = 0; m < 4; ++m) {
                const int row = row0 + ai * HALF + m * 16;
                const float rs = lds_ok ? rs_lds[wr * 64 + fr + ai * HALF + m * 16] : row_rstd(ssp, row);
                bf16_t* rowp = O + (size_t)row * NPROJ + col0;
#pragma unroll
                for (int bj = 0; bj < 2; ++bj) {
                    const f32x4 v0 = acc[ai][bj][m][0] * rs, v1 = acc[ai][bj][m][1] * rs;
                    u32x4 w; w.x = pk2(v0[0], v0[1]); w.y = pk2(v0[2], v0[3]); w.z = pk2(v1[0], v1[1]); w.w = pk2(v1[2], v1[3]);
                    *(u32x4*)(rowp + bj * HALF) = w;
                }
            }
    }
};
struct EpiOutProj {
    static constexpr bool PERM = true, AFTER_DRAIN = true;
    bf16_t* xb; float* ssp;
    DI void operator()(const f32x4 (&)[2][2][4][2], const Unit&, int, int, int, int) const {}
    DI void fused(const f32x4 (&acc)[2][2][4][2], const Unit& u, int wr, int wc, int fr, int fq, LAS unsigned char* lds, int wid, int lane) const {
        LAS float* red = (LAS float*)lds;
        const int row0 = u.pm * BM + wr * 64 + fr; const int col0 = u.pn * BM + wc * 32 + 8 * fq;
        u32x4 xo[2][4][2];
#pragma unroll
        for (int ai = 0; ai < 2; ++ai)
#pragma unroll
            for (int m = 0; m < 4; ++m)
#pragma unroll
                for (int bj = 0; bj < 2; ++bj) xo[ai][m][bj] = *(const u32x4*)(xb + (size_t)(row0 + ai * HALF + m * 16) * DM + col0 + bj * HALF);
#pragma unroll
        for (int ai = 0; ai < 2; ++ai)
#pragma unroll
            for (int m = 0; m < 4; ++m) {
                const int row = row0 + ai * HALF + m * 16; float ss = 0.f;
#pragma unroll
                for (int bj = 0; bj < 2; ++bj) {
                    const u32x4 o = xo[ai][m][bj];
                    const f32x4 a0 = acc[ai][bj][m][0], a1 = acc[ai][bj][m][1];
                    u32x4 pb;
                    pb.x = pk2(bf_lo(o.x) + a0[0], bf_hi(o.x) + a0[1]); pb.y = pk2(bf_lo(o.y) + a0[2], bf_hi(o.y) + a0[3]);
                    pb.z = pk2(bf_lo(o.z) + a1[0], bf_hi(o.z) + a1[1]); pb.w = pk2(bf_lo(o.w) + a1[2], bf_hi(o.w) + a1[3]);
                    *(u32x4*)(xb + (size_t)row * DM + col0 + bj * HALF) = pb;
                    const float y0 = bf_lo(pb.x), y1 = bf_hi(pb.x), y2 = bf_lo(pb.y), y3 = bf_hi(pb.y), y4 = bf_lo(pb.z), y5 = bf_hi(pb.z), y6 = bf_lo(pb.w), y7 = bf_hi(pb.w);
                    ss += ((y0 * y0 + y1 * y1) + (y2 * y2 + y3 * y3)) + ((y4 * y4 + y5 * y5) + (y6 * y6 + y7 * y7));
                }
                ss += __shfl_xor(ss, 16); ss += __shfl_xor(ss, 32);
                if (fq == 0) red[wc * 256 + wr * 64 + fr + ai * HALF + m * 16] = ss;
            }
        __syncthreads();
        const int tid = opaque_tid();
        if (tid < 256) ssp[(size_t)u.pn * S + u.pm * BM + tid] = (red[tid] + red[256 + tid]) + (red[512 + tid] + red[768 + tid]);
        __syncthreads();
    }
};
}

#define XB_TMO      128
#define XB_XCNT(j)  (256  + 64 * (j))
#define XB_XSUB(j)  (1280 + 64 * (j))
#define XB_XGEN(j)  (2304 + 64 * (j))
#define XB_TOP      3328
#define XB_TOPGEN   3392
#define XCD_BAR_WORDS 3456
#define XB_SPIN_CAP (1u << 20)
DI unsigned xb_ld(unsigned* p)              { return __hip_atomic_load(p, __ATOMIC_RELAXED, __HIP_MEMORY_SCOPE_AGENT); }
DI unsigned xb_add(unsigned* p, unsigned v) { return __hip_atomic_fetch_add(p, v, __ATOMIC_RELAXED, __HIP_MEMORY_SCOPE_AGENT); }
DI unsigned xb_xcc_id() { return (unsigned)__builtin_amdgcn_s_getreg((3 << 11) | 20) & 0xFu; }
#define XB_SPIN(cond, bar) do { unsigned _sp = 0; while (cond) { __builtin_amdgcn_s_sleep(1); \
    if ((++_sp & 255u) == 0u) { if (xb_ld(&(bar)[XB_TMO])) break; if (_sp > XB_SPIN_CAP) { atomicAdd(&(bar)[XB_TMO], 1u); break; } } } } while (0)
struct XcdBarrier { unsigned* bar; unsigned x; volatile LAS unsigned* st; };
DI XcdBarrier xcd_barrier_post(unsigned* bar, volatile LAS unsigned* st) {
    XcdBarrier b; b.bar = bar; b.x = xb_xcc_id(); b.st = st;
    if (threadIdx.x == 0) st[2] = xb_add(&bar[XB_XCNT(b.x)], 1u);
    return b;
}
DI void xcd_barrier_complete(unsigned* bar, unsigned x, unsigned& nloc, unsigned& nx) {
    const unsigned G = gridDim.x * gridDim.y * gridDim.z;
    unsigned sum, cnt, mine, sp = 0u;
    for (;;) {
        sum = 0u; cnt = 0u; mine = 0u;
#pragma unroll
        for (unsigned j = 0; j < 16; ++j) { const unsigned c = xb_ld(&bar[XB_XCNT(j)]); sum += c; cnt += (c > 0u) ? 1u : 0u; mine = (j == x) ? c : mine; }
        if (sum == G) break;
        __builtin_amdgcn_s_sleep(1);
        if ((++sp & 255u) == 0u) { if (xb_ld(&bar[XB_TMO])) break; if (sp > XB_SPIN_CAP) { atomicAdd(&bar[XB_TMO], 1u); break; } }
    }
    nloc = mine > 0u ? mine : 1u; nx = cnt > 0u ? cnt : 1u;
}
DI void xcd_barrier(const XcdBarrier& b) {
    asm volatile("s_waitcnt vmcnt(0)" ::: "memory");
    __syncthreads();
    if (threadIdx.x == 0) {
        unsigned* bar = b.bar;
        __builtin_amdgcn_s_waitcnt(0);
        unsigned nloc = b.st[0], nx = b.st[1];
        if (nloc == 0u) { xcd_barrier_complete(bar, b.x, nloc, nx); b.st[0] = nloc; b.st[1] = nx; }
        const unsigned old = xb_add(&bar[XB_XSUB(b.x)], 1u);
        const unsigned gen = old / nloc;
        if (old + 1u == (gen + 1u) * nloc) {
            __builtin_amdgcn_fence(__ATOMIC_RELEASE, "agent");
            asm volatile("s_waitcnt vmcnt(0)" ::: "memory");
            const unsigned og = xb_add(&bar[XB_TOP], 1u);
            const unsigned tg = og / nx;
            if (og + 1u == (tg + 1u) * nx) xb_add(&bar[XB_TOPGEN], 1u);
            else XB_SPIN(xb_ld(&bar[XB_TOPGEN]) == tg, bar);
            __builtin_amdgcn_fence(__ATOMIC_ACQUIRE, "agent");
            xb_add(&bar[XB_XGEN(b.x)], 1u);
            asm volatile("s_waitcnt vmcnt(0)" ::: "memory");
        } else {
            XB_SPIN(xb_ld(&bar[XB_XGEN(b.x)]) == gen, bar);
            __builtin_amdgcn_fence(__ATOMIC_ACQUIRE, "agent");
            asm volatile("s_waitcnt vmcnt(0)" ::: "memory");
        }
    }
    __syncthreads();
}

struct Args {
    const float* x; const float* norm_w; const float* w_in; const float* conv_w; const float* conv_b;
    const float* dt_bias; const float* a_log; const float* d_skip; const float* ssd_norm_w; const float* w_out; const float* final_norm_w;
    float* out; unsigned char* ws; int ph_lo, ph_hi;
};

DI void conv_load(const bf16_t* proj, int t0, int l0, int cc, u32x4 (&raw)[7]) {
#pragma unroll
    for (int i = 0; i < 7; ++i) {
        const int t = t0 + l0 - 3 + i;
        if (t >= 0) raw[i] = *(const u32x4*)(proj + (size_t)t * NPROJ + XOFF + cc);
        else raw[i] = (u32x4){0u, 0u, 0u, 0u};
    }
}
DI void conv_compute(const u32x4 (&raw)[7], const float* cw, const float* cb, int cc, float (&out)[4][8]) {
    float w[4][8], b[8];
#pragma unroll
    for (int j = 0; j < 4; ++j) {
        const f32x4 w0 = *(const f32x4*)(cw + j * CONVD + cc), w1 = *(const f32x4*)(cw + j * CONVD + cc + 4);
        w[j][0] = w0[0]; w[j][1] = w0[1]; w[j][2] = w0[2]; w[j][3] = w0[3]; w[j][4] = w1[0]; w[j][5] = w1[1]; w[j][6] = w1[2]; w[j][7] = w1[3];
    }
    { const f32x4 b0 = *(const f32x4*)(cb + cc), b1 = *(const f32x4*)(cb + cc + 4);
      b[0] = b0[0]; b[1] = b0[1]; b[2] = b0[2]; b[3] = b0[3]; b[4] = b1[0]; b[5] = b1[1]; b[6] = b1[2]; b[7] = b1[3]; }
#pragma unroll
    for (int i = 0; i < 4; ++i)
#pragma unroll
        for (int e = 0; e < 8; ++e) {
            float a = b[e];
#pragma unroll
            for (int j = 0; j < 4; ++j) {
                const unsigned wd = raw[i + j][e >> 1];
                a += w[j][e] * ((e & 1) ? bf_hi(wd) : bf_lo(wd));
            }
            out[i][e] = silu_f(a);
        }
}

DI void head_dt(const float* dtraw, const float* dt_bias, const float* a_log, int t0, int h, int lane, float& dtv, float& acum) {
    const float xr = dtraw[(size_t)(t0 + lane) * 32 + h] + dt_bias[h];
    dtv = (xr > 20.f) ? xr : log1pf(expf(xr));
    const float A = -expf(a_log[h]);
    float v = dtv * A;
#pragma unroll
    for (int o = 1; o < 64; o <<= 1) { const float t = __shfl_up(v, o); if (lane >= o) v += t; }
    acum = v;
}

DI void transpose_item(const float* W, int Nsrc, int k0, int n0, const float* nw, bf16_t* dst, int Kdst, LAS float* scr, int lane) {
    f32x4 v[16]; float sc[16];
#pragma unroll
    for (int i = 0; i < 16; ++i) {
        const int kk = 8 * i + (lane >> 3);
        v[i] = __builtin_nontemporal_load((const f32x4*)(W + (size_t)(k0 + kk) * Nsrc + n0 + 4 * (lane & 7)));
        sc[i] = nw ? nw[k0 + kk] : 1.0f;
    }
#pragma unroll
    for (int i = 0; i < 16; ++i) {
        const int kk = 8 * i + (lane >> 3);
        LAS float* p = scr + kk * 33 + 4 * (lane & 7);
        p[0] = v[i][0] * sc[i]; p[1] = v[i][1] * sc[i]; p[2] = v[i][2] * sc[i]; p[3] = v[i][3] * sc[i];
    }
    asm volatile("s_waitcnt lgkmcnt(0)" ::: "memory");
    const int c = lane & 15;
#pragma unroll
    for (int j = 0; j < 8; ++j) {
        const int n = (lane >> 4) + 4 * j; const LAS float* s = scr + (8 * c) * 33 + n;
        u32x4 o; o.x = pk2(s[0 * 33], s[1 * 33]); o.y = pk2(s[2 * 33], s[3 * 33]); o.z = pk2(s[4 * 33], s[5 * 33]); o.w = pk2(s[6 * 33], s[7 * 33]);
        __builtin_nontemporal_store(o, (u32x4*)(dst + (size_t)n * Kdst + k0 + 8 * c));
    }
    asm volatile("s_waitcnt lgkmcnt(0)" ::: "memory");
}

constexpr int CV_IN_ITEMS = 16 * 417, CV_OUT_ITEMS = 32 * 64, CV_PER_L = CV_IN_ITEMS + CV_OUT_ITEMS;
#ifndef CV_SLOT_N
#define CV_SLOT_N 8720
#endif
constexpr int CV_SLOT = CV_SLOT_N;
DI void convert_item(const Args& a, int l, int r, LAS float* scr, int lane) {
    bf16_t* win = (bf16_t*)(a.ws + WS_WIN); bf16_t* wdt = (bf16_t*)(a.ws + WS_WDT); bf16_t* wout = (bf16_t*)(a.ws + WS_WOUT);
    if (r < CV_IN_ITEMS) {
        const int nb = r % 417, kb = r / 417; const int n0 = nb * 32;
        bf16_t* dst;
        if (nb < 160) dst = win + ((size_t)l * NPROJ + n0) * DM;
        else if (nb == 160) dst = wdt + (size_t)l * 32 * DM;
        else dst = win + ((size_t)l * NPROJ + n0 - 32) * DM;
        transpose_item(a.w_in + (size_t)l * DM * INCOLS, INCOLS, kb * 128, n0, a.norm_w + l * DM, dst, DM, scr, lane);
    } else {
        r -= CV_IN_ITEMS; const int nb = r % 64, kb = r / 64;
        transpose_item(a.w_out + (size_t)l * DMIX * DM, DM, kb * 128, nb * 32, nullptr, wout + ((size_t)l * DM + nb * 32) * DMIX, DMIX, scr, lane);
    }
}

DI void phase_prologue(const Args& a, LAS unsigned char* lds) {
    const int tid = opaque_tid(), lane = tid & 63, wave = tid >> 6;
    const int gw = blockIdx.x * 8 + wave, NGW = gridDim.x * 8;
    LAS float* scr = (LAS float*)(lds + wave * 16896);
    constexpr int PRO_ITEMS = CV_PER_L + (NL - 1) * (CV_PER_L - CV_SLOT);
    for (int it = gw; it < PRO_ITEMS; it += NGW) {
        if (it < CV_PER_L) convert_item(a, 0, it, scr, lane);
        else { const int j = it - CV_PER_L; convert_item(a, 1 + j / (CV_PER_L - CV_SLOT), j % (CV_PER_L - CV_SLOT), scr, lane); }
    }
    bf16_t* xb = (bf16_t*)(a.ws + WS_XB); float* ssp = (float*)(a.ws + WS_SSP);
    for (int row = gw; row < S; row += NGW) {
        const f32x4* xr = (const f32x4*)(a.x + (size_t)row * DM) + lane;
        float ss = 0.f;
#pragma unroll
        for (int j = 0; j < 8; ++j) {
            const f32x4 v = xr[64 * j];
            ss += (v[0] * v[0] + v[1] * v[1]) + (v[2] * v[2] + v[3] * v[3]);
            u32x2 pb; pb.x = pk2(v[0], v[1]); pb.y = pk2(v[2], v[3]);
            *(u32x2*)(xb + (size_t)row * DM + 256 * j + 4 * lane) = pb;
        }
#pragma unroll
        for (int o = 1; o < 64; o <<= 1) ss += __shfl_xor(ss, o);
        if (lane < 8) ssp[lane * S + row] = (lane == 0) ? ss : 0.f;
    }
}

DI void dt_gemm(const Args& a, int layer, int blk, int nblk, LAS unsigned char* lds) {
    const int tid = opaque_tid(), lane = tid & 63, wave = tid >> 6, fr = lane & 15, q4 = lane >> 4;
    const bf16_t* xb = (const bf16_t*)(a.ws + WS_XB); const bf16_t* wdt = (const bf16_t*)(a.ws + WS_WDT) + (size_t)layer * 32 * DM;
    const float* ssp = (const float*)(a.ws + WS_SSP); float* dtraw = (float*)(a.ws + WS_DTRAW);
    LAS float* P = (LAS float*)lds;
    for (int tg = blk; tg < S / 64; tg += nblk) {
        const int row0 = tg * 64, kw = wave * 256;
        bf16x8 b0[8], b1[8];
#pragma unroll
        for (int ks = 0; ks < 8; ++ks) {
            b0[ks] = *(const bf16x8*)(wdt + (size_t)fr * DM + kw + ks * 32 + q4 * 8);
            b1[ks] = *(const bf16x8*)(wdt + (size_t)(16 + fr) * DM + kw + ks * 32 + q4 * 8);
        }
#pragma unroll
        for (int t = 0; t < 4; ++t) {
            bf16x8 av[8];
#pragma unroll
            for (int ks = 0; ks < 8; ++ks) av[ks] = *(const bf16x8*)(xb + (size_t)(row0 + 16 * t + fr) * DM + kw + ks * 32 + q4 * 8);
            f32x4 acc0 = {0.f, 0.f, 0.f, 0.f}, acc1 = {0.f, 0.f, 0.f, 0.f};
#pragma unroll
            for (int ks = 0; ks < 8; ++ks) { acc0 = mfma16(av[ks], b0[ks], acc0); acc1 = mfma16(av[ks], b1[ks], acc1); }
#pragma unroll
            for (int r = 0; r < 4; ++r) { P[(((wave * 4 + t) * 2 + 0) * 4 + r) * 64 + lane] = acc0[r]; P[(((wave * 4 + t) * 2 + 1) * 4 + r) * 64 + lane] = acc1[r]; }
        }
        __syncthreads();
#pragma unroll
        for (int i = 0; i < 4; ++i) {
            const int o = tid + 512 * i;
            const int ln = o & 63, r = (o >> 6) & 3, j = (o >> 8) & 1, t = o >> 9;
            float sum = 0.f;
#pragma unroll
            for (int w = 0; w < 8; ++w) sum += P[w * 2048 + o];
            const int row = row0 + 16 * t + 4 * (ln >> 4) + r;
            dtraw[(size_t)row * 32 + 16 * j + (ln & 15)] = sum * row_rstd(ssp, row);
        }
        __syncthreads();
    }
}

constexpr int TS = 136, XS_STR = 520;
DI void ssd_states_unit(const Args& a, int layer, int c, int g, LAS unsigned char* lds) {
    const int tid = opaque_tid(), lane = tid & 63, wave = tid >> 6, fr = lane & 15, q4 = lane >> 4;
    const int t0 = c * 64, h = g * 8 + wave;
    const bf16_t* proj = (const bf16_t*)(a.ws + WS_PROJ);
    bf16_t* xact = (bf16_t*)(a.ws + WS_XACT);
    LAS unsigned char* BS = lds;
    LAS unsigned char* XS = lds + 64 * TS * 2;
    LAS float* WL = (LAS float*)(lds + 64 * TS * 2 + 64 * XS_STR * 2);
    {
        float dtv, ac;
        head_dt((const float*)(a.ws + WS_DTRAW), a.dt_bias + layer * NH, a.a_log + layer * NH, t0, h, lane, dtv, ac);
        const float alast = __shfl(ac, 63);
        WL[wave * 64 + lane] = __expf(alast - ac) * dtv;
        if (lane == 0) ((float*)(a.ws + WS_CDEC))[c * NH + h] = __expf(alast);
    }
    __syncthreads();
    const float* cw = a.conv_w + (size_t)layer * 4 * CONVD; const float* cb = a.conv_b + (size_t)layer * CONVD;
    u32x4 raw3[3][7];
#pragma unroll
    for (int k = 0; k < 3; ++k) {
        const int it = tid + 512 * k, cgi = it % 96, l0 = (it / 96) * 4;
        const int cc = (cgi < 64) ? g * 512 + cgi * 8 : (cgi < 80) ? 2048 + g * 128 + (cgi - 64) * 8 : 2560 + g * 128 + (cgi - 80) * 8;
        conv_load(proj, t0, l0, cc, raw3[k]);
    }
#pragma unroll
    for (int k = 0; k < 3; ++k) {
        const int it = tid + 512 * k;
        const int cgi = it % 96, l0 = (it / 96) * 4;
        const int cc = (cgi < 64) ? g * 512 + cgi * 8 : (cgi < 80) ? 2048 + g * 128 + (cgi - 64) * 8 : 2560 + g * 128 + (cgi - 80) * 8;
        float o[4][8];
        conv_compute(raw3[k], cw, cb, cc, o);
#pragma unroll
        for (int i = 0; i < 4; ++i) {
            u32x4 v; v.x = pk2(o[i][0], o[i][1]); v.y = pk2(o[i][2], o[i][3]); v.z = pk2(o[i][4], o[i][5]); v.w = pk2(o[i][6], o[i][7]);
            *(u32x4*)(xact + (size_t)(t0 + l0 + i) * CONVD + cc) = v;
            if (cgi >= 64 && cgi < 80) *(LAS u32x4*)(BS + ((l0 + i) * TS + (cgi - 64) * 8) * 2) = v;
        }
        if (cgi < 64) {
            const int hd = cgi >> 3;
#pragma unroll
            for (int i = 0; i < 4; ++i) {
                const float w = WL[hd * 64 + l0 + i];
                u32x4 v; v.x = pk2(o[i][0] * w, o[i][1] * w); v.y = pk2(o[i][2] * w, o[i][3] * w); v.z = pk2(o[i][4] * w, o[i][5] * w); v.w = pk2(o[i][6] * w, o[i][7] * w);
                *(LAS u32x4*)(XS + ((l0 + i) * XS_STR + cgi * 8) * 2) = v;
            }
        }
    }
    __syncthreads();
    f32x4 acc[8][4];
#pragma unroll
    for (int nb = 0; nb < 8; ++nb)
#pragma unroll
        for (int pb = 0; pb < 4; ++pb) acc[nb][pb] = (f32x4){0.f, 0.f, 0.f, 0.f};
#pragma unroll
    for (int ks = 0; ks < 2; ++ks) {
        bf16x8 xf[4];
#pragma unroll
        for (int pb = 0; pb < 4; ++pb) xf[pb] = tr_frag(XS, XS_STR, ks * 32 + q4 * 8, wave * 64 + pb * 16, fr);
#pragma unroll
        for (int nb = 0; nb < 8; ++nb) {
            const bf16x8 bfr = tr_frag(BS, TS, ks * 32 + q4 * 8, nb * 16, fr);
#pragma unroll
            for (int pb = 0; pb < 4; ++pb) acc[nb][pb] = mfma16(bfr, xf[pb], acc[nb][pb]);
        }
    }
    bf16_t* st = (bf16_t*)(a.ws + WS_STATES) + ((size_t)(c * NH + h) * 64) * 128;
#pragma unroll
    for (int nb = 0; nb < 8; ++nb)
#pragma unroll
        for (int pb = 0; pb < 4; ++pb) {
            u32x2 v; v.x = pk2(acc[nb][pb][0], acc[nb][pb][1]); v.y = pk2(acc[nb][pb][2], acc[nb][pb][3]);
            *(u32x2*)(st + (size_t)(pb * 16 + fr) * 128 + nb * 16 + 4 * q4) = v;
        }
    __syncthreads();
}

DI void phase_scan(const Args& a, unsigned char* states_base) {
    const int gt = blockIdx.x * 512 + opaque_tid(), NT = gridDim.x * 512;
    unsigned* st = (unsigned*)states_base; const float* cdec = (const float*)(a.ws + WS_CDEC);
    constexpr int PAIRS = NH * 64 * 128 / 2;
    for (int e = gt; e < PAIRS; e += NT) {
        const int h = e >> 12;
        float r0 = 0.f, r1 = 0.f;
        for (int c0 = 0; c0 < NCHUNK; c0 += 8) {
            unsigned v[8]; float d[8];
#pragma unroll
            for (int j = 0; j < 8; ++j) { v[j] = st[(size_t)(c0 + j) * PAIRS + e]; d[j] = cdec[(c0 + j) * NH + h]; }
#pragma unroll
            for (int j = 0; j < 8; ++j) {
                st[(size_t)(c0 + j) * PAIRS + e] = pk2(r0, r1);
                r0 = r0 * d[j] + bf_lo(v[j]); r1 = r1 * d[j] + bf_hi(v[j]);
            }
        }
    }
}

DI void ssd_out_unit(const Args& a, int layer, int c, int g, LAS unsigned char* lds) {
    const int tid = opaque_tid(), lane = tid & 63, wave = tid >> 6, fr = lane & 15, q4 = lane >> 4;
    const int t0 = c * 64, h = g * 8 + wave;
    const bf16_t* proj = (const bf16_t*)(a.ws + WS_PROJ);
    const bf16_t* xact = (const bf16_t*)(a.ws + WS_XACT);
    LAS unsigned char* CS = lds;
    LAS unsigned char* BS = lds + 64 * TS * 2;
    LAS unsigned char* XS = lds + 2 * 64 * TS * 2;
    LAS float* GS = (LAS float*)(lds + 2 * 64 * TS * 2 + 64 * XS_STR * 2);
    LAS float* DTS = GS + 64 * 68;
    LAS float* ACS = DTS + 512;
    LAS float* SSQ = ACS + 512;
    const bf16_t* prev = (const bf16_t*)(a.ws + WS_STATES) + ((size_t)(c * NH + h) * 64) * 128;
    bf16x8 pf[4][4];
#pragma unroll
    for (int ks = 0; ks < 4; ++ks)
#pragma unroll
        for (int pb = 0; pb < 4; ++pb) pf[ks][pb] = *(const bf16x8*)(prev + (size_t)(pb * 16 + fr) * 128 + ks * 32 + q4 * 8);
    u32x2 zr[4][4];
#pragma unroll
    for (int lb = 0; lb < 4; ++lb)
#pragma unroll
        for (int pb = 0; pb < 4; ++pb) zr[lb][pb] = *(const u32x2*)(proj + (size_t)(t0 + lb * 16 + fr) * NPROJ + ZOFF + h * 64 + pb * 16 + 4 * q4);
    {
        float dtv, ac;
        head_dt((const float*)(a.ws + WS_DTRAW), a.dt_bias + layer * NH, a.a_log + layer * NH, t0, h, lane, dtv, ac);
        DTS[wave * 64 + lane] = dtv; ACS[wave * 64 + lane] = ac;
    }
    {
        u32x4 xv[8], bv[2], cv[2];
#pragma unroll
        for (int i = 0; i < 8; ++i) { const int piece = tid + 512 * i, row = piece >> 6, ch = piece & 63; xv[i] = *(const u32x4*)(xact + (size_t)(t0 + row) * CONVD + g * 512 + ch * 8); }
#pragma unroll
        for (int i = 0; i < 2; ++i) { const int piece = tid + 512 * i, row = piece >> 4, ch = piece & 15;
            bv[i] = *(const u32x4*)(xact + (size_t)(t0 + row) * CONVD + 2048 + g * 128 + ch * 8); cv[i] = *(const u32x4*)(xact + (size_t)(t0 + row) * CONVD + 2560 + g * 128 + ch * 8); }
#pragma unroll
        for (int i = 0; i < 8; ++i) { const int piece = tid + 512 * i, row = piece >> 6, ch = piece & 63; *(LAS u32x4*)(XS + (row * XS_STR + ch * 8) * 2) = xv[i]; }
#pragma unroll
        for (int i = 0; i < 2; ++i) { const int piece = tid + 512 * i, row = piece >> 4, ch = piece & 15;
            *(LAS u32x4*)(BS + (row * TS + ch * 8) * 2) = bv[i]; *(LAS u32x4*)(CS + (row * TS + ch * 8) * 2) = cv[i]; }
    }
    __syncthreads();
    {
        const int lb = wave >> 1;
#pragma unroll
        for (int sj = 0; sj < 2; ++sj) {
            const int sb = 2 * (wave & 1) + sj;
            f32x4 gacc = {0.f, 0.f, 0.f, 0.f};
#pragma unroll
            for (int ks = 0; ks < 4; ++ks) {
                const bf16x8 cf = *(const LAS bf16x8*)(CS + ((lb * 16 + fr) * TS + ks * 32 + q4 * 8) * 2);
                const bf16x8 bfr = *(const LAS bf16x8*)(BS + ((sb * 16 + fr) * TS + ks * 32 + q4 * 8) * 2);
                gacc = mfma16(cf, bfr, gacc);
            }
#pragma unroll
            for (int r = 0; r < 4; ++r) GS[(lb * 16 + 4 * q4 + r) * 68 + sb * 16 + fr] = gacc[r];
        }
    }
    __syncthreads();
    f32x4 acc[4][4];
#pragma unroll
    for (int pb = 0; pb < 4; ++pb)
#pragma unroll
        for (int lb = 0; lb < 4; ++lb) acc[pb][lb] = (f32x4){0.f, 0.f, 0.f, 0.f};
#pragma unroll
    for (int ks = 0; ks < 4; ++ks) {
        bf16x8 cf[4];
#pragma unroll
        for (int lb = 0; lb < 4; ++lb) cf[lb] = *(const LAS bf16x8*)(CS + ((lb * 16 + fr) * TS + ks * 32 + q4 * 8) * 2);
#pragma unroll
        for (int pb = 0; pb < 4; ++pb)
#pragma unroll
            for (int lb = 0; lb < 4; ++lb) acc[pb][lb] = mfma16(pf[ks][pb], cf[lb], acc[pb][lb]);
    }
    float acl[4];
#pragma unroll
    for (int lb = 0; lb < 4; ++lb) {
        acl[lb] = ACS[wave * 64 + lb * 16 + fr];
        const float el = __expf(acl[lb]);
#pragma unroll
        for (int pb = 0; pb < 4; ++pb) acc[pb][lb] *= el;
    }
    const float Dh = a.d_skip[layer * NH + h];
#pragma unroll
    for (int ks2 = 0; ks2 < 2; ++ks2) {
        float as8[8], ds8[8];
        {
            const f32x4 a0 = *(const LAS f32x4*)(ACS + wave * 64 + ks2 * 32 + q4 * 8), a1 = *(const LAS f32x4*)(ACS + wave * 64 + ks2 * 32 + q4 * 8 + 4);
            const f32x4 d0 = *(const LAS f32x4*)(DTS + wave * 64 + ks2 * 32 + q4 * 8), d1 = *(const LAS f32x4*)(DTS + wave * 64 + ks2 * 32 + q4 * 8 + 4);
#pragma unroll
            for (int j = 0; j < 4; ++j) { as8[j] = a0[j]; as8[4 + j] = a1[j]; ds8[j] = d0[j]; ds8[4 + j] = d1[j]; }
        }
        bf16x8 xf[4];
#pragma unroll
        for (int pb = 0; pb < 4; ++pb) xf[pb] = tr_frag(XS, XS_STR, ks2 * 32 + q4 * 8, wave * 64 + pb * 16, fr);
#pragma unroll
        for (int lb = 0; lb < 4; ++lb) {
            if (ks2 * 32 > lb * 16 + 15) continue;
            const int l = lb * 16 + fr;
            const f32x4 g0 = *(const LAS f32x4*)(GS + l * 68 + ks2 * 32 + q4 * 8), g1 = *(const LAS f32x4*)(GS + l * 68 + ks2 * 32 + q4 * 8 + 4);
            float mv[8];
#pragma unroll
            for (int j = 0; j < 8; ++j) {
                const int s_ = ks2 * 32 + q4 * 8 + j;
                const float gv = (j < 4) ? g0[j & 3] : g1[j & 3];
                float v = (s_ <= l) ? gv * __expf(acl[lb] - as8[j]) * ds8[j] : 0.f;
                if (s_ == l) v += Dh;
                mv[j] = v;
            }
            u32x4 mp; mp.x = pk2(mv[0], mv[1]); mp.y = pk2(mv[2], mv[3]); mp.z = pk2(mv[4], mv[5]); mp.w = pk2(mv[6], mv[7]);
            const bf16x8 mf = __builtin_bit_cast(bf16x8, mp);
#pragma unroll
            for (int pb = 0; pb < 4; ++pb) acc[pb][lb] = mfma16(xf[pb], mf, acc[pb][lb]);
        }
    }
#pragma unroll
    for (int lb = 0; lb < 4; ++lb) {
        const int l = lb * 16 + fr; float ss = 0.f;
#pragma unroll
        for (int pb = 0; pb < 4; ++pb) {
            const u32x2 z2 = zr[lb][pb];
            f32x4 y = acc[pb][lb];
            y[0] *= silu_f(bf_lo(z2.x)); y[1] *= silu_f(bf_hi(z2.x)); y[2] *= silu_f(bf_lo(z2.y)); y[3] *= silu_f(bf_hi(z2.y));
            acc[pb][lb] = y;
            ss += (y[0] * y[0] + y[1] * y[1]) + (y[2] * y[2] + y[3] * y[3]);
        }
        ss += __shfl_xor(ss, 16); ss += __shfl_xor(ss, 32);
        if (q4 == 0) SSQ[wave * 64 + l] = ss;
    }
    __syncthreads();
    bf16_t* mix = (bf16_t*)(a.ws + WS_MIX);
    const float* nw = a.ssd_norm_w + (size_t)layer * 2048 + h * 64;
    f32x4 wv[4];
#pragma unroll
    for (int pb = 0; pb < 4; ++pb) wv[pb] = *(const f32x4*)(nw + pb * 16 + 4 * q4);
#pragma unroll
    for (int lb = 0; lb < 4; ++lb) {
        const int l = lb * 16 + fr; float tot = 0.f;
#pragma unroll
        for (int w2 = 0; w2 < 8; ++w2) tot += SSQ[w2 * 64 + l];
        const float rs = rsqrtf(tot * (1.0f / 512.0f) + EPS);
#pragma unroll
        for (int pb = 0; pb < 4; ++pb) {
            const f32x4 y = acc[pb][lb];
            u32x2 o; o.x = pk2(y[0] * rs * wv[pb][0], y[1] * rs * wv[pb][1]); o.y = pk2(y[2] * rs * wv[pb][2], y[3] * rs * wv[pb][3]);
            *(u32x2*)(mix + (size_t)(t0 + l) * DMIX + h * 64 + pb * 16 + 4 * q4) = o;
        }
    }
    __syncthreads();
}

typedef float f32x2 __attribute__((ext_vector_type(2)));
template <bool MASK> DI void sb_block(const f32x4& zacc, float scale2, int s0, int t, float m1, float m2, float& R, unsigned& w0, unsigned& w1) {
    const f32x2 za = (f32x2){zacc[0], zacc[1]} * scale2, zb = (f32x2){zacc[2], zacc[3]} * scale2;
    f32x2 ea, eb;
    ea.x = __builtin_amdgcn_exp2f(-fabsf(za.x)); ea.y = __builtin_amdgcn_exp2f(-fabsf(za.y)); eb.x = __builtin_amdgcn_exp2f(-fabsf(zb.x)); eb.y = __builtin_amdgcn_exp2f(-fabsf(zb.y));
    const f32x2 ua = ea + 1.0f, ub = eb + 1.0f;
    f32x2 la, lb, ma, mb;
    la.x = __builtin_amdgcn_logf(ua.x); la.y = __builtin_amdgcn_logf(ua.y); lb.x = __builtin_amdgcn_logf(ub.x); lb.y = __builtin_amdgcn_logf(ub.y);
    ma.x = fmaxf(za.x, 0.f); ma.y = fmaxf(za.y, 0.f); mb.x = fmaxf(zb.x, 0.f); mb.y = fmaxf(zb.y, 0.f);
    f32x2 spa = ma + la, spb = mb + lb;
    bool v0 = true, v1 = true, v2 = true, v3 = true;
    if (MASK) { v0 = s0 < t; v1 = s0 + 1 < t; v2 = s0 + 2 < t; v3 = s0 + 3 < t;
        spa.x = v0 ? spa.x : 0.f; spa.y = v1 ? spa.y : 0.f; spb.x = v2 ? spb.x : 0.f; spb.y = v3 ? spb.y : 0.f; }
    const float suf3 = spb.y, suf2 = spb.x + suf3, suf1 = spa.y + suf2, suf0 = spa.x + suf1;
    const auto s16 = __builtin_amdgcn_permlane16_swap(__float_as_uint(suf0), __float_as_uint(suf0), false, false);
    const float po = __uint_as_float(s16[1]);
    const float psum = __uint_as_float(s16[0]) + po;
    const auto s32 = __builtin_amdgcn_permlane32_swap(__float_as_uint(psum), __float_as_uint(psum), false, false);
    const float hlo = __uint_as_float(s32[0]), hhi = __uint_as_float(s32[1]);
    const float nb = -(R + (m1 * po + m2 * hhi));
    R += hlo + hhi;
    const f32x2 aa = (za + nb) - (f32x2){suf0, suf1}, ab = (zb + nb) - (f32x2){suf2, suf3};
    float x0 = __builtin_amdgcn_exp2f(aa.x), x1 = __builtin_amdgcn_exp2f(aa.y), x2 = __builtin_amdgcn_exp2f(ab.x), x3 = __builtin_amdgcn_exp2f(ab.y);
    if (MASK) { x0 = v0 ? x0 : 0.f; x1 = v1 ? x1 : 0.f; x2 = v2 ? x2 : 0.f; x3 = v3 ? x3 : 0.f; }
    w0 = pk2(x0, x1); w1 = pk2(x2, x3);
}

constexpr int NTB = 1, ATT_Q = 128 * NTB;
DI void attn_unit(const Args& a, int h, int qb, LAS unsigned char* lds) {
    const int tid = opaque_tid(), lane = tid & 63, wave = tid >> 6, fr = lane & 15, q4 = lane >> 4;
    const bf16_t* proj = (const bf16_t*)(a.ws + WS_PROJ);
    constexpr int KVB = 64 * TS * 2;
    LAS int* FLG = (LAS int*)(lds + 4 * KVB);
    const int q0 = qb * ATT_Q, tq0 = q0 + wave * 16 * NTB, tmax = tq0 + 16 * NTB - 2;
    const float scale2 = 0.08838834764831845f * 1.4426950408889634f;
    constexpr float THR2 = 151.0f;
    bf16x8 qf[NTB][4];
#pragma unroll
    for (int tb = 0; tb < NTB; ++tb)
#pragma unroll
        for (int ks = 0; ks < 4; ++ks) qf[tb][ks] = *(const bf16x8*)(proj + (size_t)(tq0 + tb * 16 + fr) * NPROJ + QOFF + h * 128 + ks * 32 + q4 * 8);
    f32x4 oacc[NTB][8];
    u32x2 gpre[NTB][8];
#pragma unroll
    for (int tb = 0; tb < NTB; ++tb)
#pragma unroll
        for (int db = 0; db < 8; ++db) {
            oacc[tb][db] = (f32x4){0.f, 0.f, 0.f, 0.f};
            gpre[tb][db] = *(const u32x2*)(proj + (size_t)(tq0 + tb * 16 + fr) * NPROJ + GOFF + h * 128 + db * 16 + 4 * q4);
        }
    float R[NTB];
#pragma unroll
    for (int tb = 0; tb < NTB; ++tb) R[tb] = 0.f;
    const float m1 = (q4 & 1) ? 0.f : 1.f, m2 = (q4 < 2) ? 1.f : 0.f;
    bool fin = false;
    int b = 0;
    const int kt_top = (q0 + ATT_Q - 1) >> 6;
    u32x4 kreg[2], vreg[2];
    const int prow = tid >> 4, pch = tid & 15;
    {
        const bf16_t* src = proj + (size_t)(kt_top * 64 + prow) * NPROJ + h * 128 + pch * 8;
        kreg[0] = *(const u32x4*)(src + KOFF); vreg[0] = *(const u32x4*)(src + VOFF);
        kreg[1] = *(const u32x4*)(src + (size_t)32 * NPROJ + KOFF); vreg[1] = *(const u32x4*)(src + (size_t)32 * NPROJ + VOFF);
    }
    for (int kt = kt_top; kt >= 0; --kt) {
        const int k0 = kt * 64;
        LAS unsigned char* KS = lds + b * 2 * KVB; LAS unsigned char* VS = KS + KVB;
        *(LAS u32x4*)(KS + (prow * TS + pch * 8) * 2) = kreg[0]; *(LAS u32x4*)(KS + ((prow + 32) * TS + pch * 8) * 2) = kreg[1];
        *(LAS u32x4*)(VS + (prow * TS + pch * 8) * 2) = vreg[0]; *(LAS u32x4*)(VS + ((prow + 32) * TS + pch * 8) * 2) = vreg[1];
        if (lane == 0) FLG[b * 8 + wave] = fin ? 1 : 0;
        __syncthreads();
        int allfin = 1;
#pragma unroll
        for (int w2 = 0; w2 < 8; ++w2) allfin &= FLG[b * 8 + w2];
        if (allfin) break;
        if (kt > 0) {
            const bf16_t* src = proj + (size_t)(k0 - 64 + prow) * NPROJ + h * 128 + pch * 8;
            kreg[0] = *(const u32x4*)(src + KOFF); vreg[0] = *(const u32x4*)(src + VOFF);
            kreg[1] = *(const u32x4*)(src + (size_t)32 * NPROJ + KOFF); vreg[1] = *(const u32x4*)(src + (size_t)32 * NPROJ + VOFF);
        }
        if (!fin && k0 <= tmax) {
#pragma unroll
            for (int kk = 1; kk >= 0; --kk) {
                u32x4 wp[NTB];
#pragma unroll
                for (int tb = 0; tb < NTB; ++tb) wp[tb] = (u32x4){0u, 0u, 0u, 0u};
                bool any = false;
#pragma unroll
                for (int half = 1; half >= 0; --half) {
                    const int kb = 2 * kk + half, kbase = k0 + 16 * kb;
                    if (fin || kbase > tmax) continue;
                    any = true;
                    f32x4 z[NTB];
#pragma unroll
                    for (int tb = 0; tb < NTB; ++tb) z[tb] = (f32x4){0.f, 0.f, 0.f, 0.f};
#pragma unroll
                    for (int ks = 0; ks < 4; ++ks) {
                        const bf16x8 kf = *(const LAS bf16x8*)(KS + ((kb * 16 + fr) * TS + ks * 32 + q4 * 8) * 2);
#pragma unroll
                        for (int tb = 0; tb < NTB; ++tb) z[tb] = mfma16(kf, qf[tb][ks], z[tb]);
                    }
                    bool ok = true;
#pragma unroll
                    for (int tb = 0; tb < NTB; ++tb) {
                        const int t = tq0 + tb * 16 + fr;
                        unsigned w0, w1;
                        sb_block<true>(z[tb], scale2, kbase + 4 * q4, t, m1, m2, R[tb], w0, w1);
                        if (half == 0) { wp[tb].x = w0; wp[tb].y = w1; } else { wp[tb].z = w0; wp[tb].w = w1; }
                        ok = ok && (R[tb] >= THR2);
                    }
                    fin = __all(ok);
                }
                if (any) {
#pragma unroll
                    for (int db = 0; db < 8; ++db) {
                        LAS unsigned char* vp = VS + ((kk * 32 + 4 * q4 + (fr >> 2)) * TS + db * 16 + 4 * (fr & 3)) * 2;
                        const s16x4 lo = __builtin_amdgcn_ds_read_tr16_b64_v4i16((LAS s16x4*)vp);
                        const s16x4 hi = __builtin_amdgcn_ds_read_tr16_b64_v4i16((LAS s16x4*)(vp + 16 * TS * 2));
                        bf16x8 vf; vf[0] = lo[0]; vf[1] = lo[1]; vf[2] = lo[2]; vf[3] = lo[3]; vf[4] = hi[0]; vf[5] = hi[1]; vf[6] = hi[2]; vf[7] = hi[3];
#pragma unroll
                        for (int tb = 0; tb < NTB; ++tb) oacc[tb][db] = mfma16(vf, __builtin_bit_cast(bf16x8, wp[tb]), oacc[tb][db]);
                    }
                }
            }
        }
        b ^= 1;
    }
    bf16_t* mix = (bf16_t*)(a.ws + WS_MIX);
#pragma unroll
    for (int tb = 0; tb < NTB; ++tb) {
        const int t = tq0 + tb * 16 + fr;
#pragma unroll
        for (int db = 0; db < 8; ++db) {
            const u32x2 gr = gpre[tb][db];
            const f32x4 o = oacc[tb][db];
            u32x2 ov; ov.x = pk2(o[0] * silu_f(bf_lo(gr.x)), o[1] * silu_f(bf_hi(gr.x))); ov.y = pk2(o[2] * silu_f(bf_lo(gr.y)), o[3] * silu_f(bf_hi(gr.y)));
            *(u32x2*)(mix + (size_t)t * DMIX + 2048 + h * 128 + db * 16 + 4 * q4) = ov;
        }
    }
    __syncthreads();
}

DI void phase_final(const Args& a) {
    const int tid = opaque_tid(), lane = tid & 63, wave = tid >> 6;
    const int gw = blockIdx.x * 8 + wave, NGW = gridDim.x * 8;
    const bf16_t* xb = (const bf16_t*)(a.ws + WS_XB); const float* ssp = (const float*)(a.ws + WS_SSP);
    for (int row = gw; row < S; row += NGW) {
        const float rs = row_rstd(ssp, row);
        const u32x2* xr = (const u32x2*)(xb + (size_t)row * DM) + lane;
        const f32x4* wr = (const f32x4*)a.final_norm_w + lane;
        f32x4* orow = (f32x4*)(a.out + (size_t)row * DM) + lane;
#pragma unroll
        for (int j = 0; j < 8; ++j) {
            const u32x2 xv = xr[64 * j]; const f32x4 w = wr[64 * j];
            f32x4 o; o[0] = bf_lo(xv.x) * rs * w[0]; o[1] = bf_hi(xv.x) * rs * w[1]; o[2] = bf_lo(xv.y) * rs * w[2]; o[3] = bf_hi(xv.y) * rs * w[3];
            orow[64 * j] = o;
        }
    }
}

__global__ void __launch_bounds__(512, 2) hybrid_fwd(Args a) {
    extern __shared__ __attribute__((aligned(16))) unsigned char lds_raw[];
    LAS unsigned char* lds = (LAS unsigned char*)lds_raw;
    const int G = gridDim.x, bx = blockIdx.x;
    volatile LAS unsigned* bst = (volatile LAS unsigned*)(lds + LDS_BYTES - 16);
    if (threadIdx.x < 4) bst[threadIdx.x] = 0u;
    __syncthreads();
    if (bx == 0) for (int i = threadIdx.x; i < 4096; i += 512) ((unsigned*)(a.ws + WS_BAR))[i] = 0u;
    XcdBarrier bar; bar.bar = (unsigned*)(a.ws + WS_BAR); bar.x = xb_xcc_id(); bar.st = bst;
    int vb = bx;
    int rep = 0;
    for (int ph = a.ph_lo; ph < a.ph_hi;) {
        int ptype;
        if (ph == 0) ptype = 1; else if (ph == NPHASE - 1) ptype = 512; else { const int sub = (ph - 1) % 5; ptype = sub == 0 ? 2 : sub == 1 ? (8 | 16) : sub == 2 ? 32 : sub == 3 ? 64 : 128; }
        const bool dummy = (DUPM & ptype) && rep == 0;
        if (ph == 0) {
#if !(SKIPM & 1)
            phase_prologue(a, lds);
#endif
        } else if (ph == NPHASE - 1) {
            phase_final(a);
        } else {
            const int layer = (ph - 1) / 5, sub = (ph - 1) % 5;
            if (sub == 0) {
                pg8::Gemm g; g.A = (const bf16_t*)(a.ws + WS_XB); g.Bt = (const bf16_t*)(a.ws + WS_WIN) + (size_t)layer * NPROJ * DM; g.M = S; g.N = NPROJ; g.K = DM;
                pg8::StaticOrder so; so.init(S, NPROJ, G, vb);
                pg8::EpiInProj e; e.O = (bf16_t*)(a.ws + WS_PROJ); e.ssp = (const float*)(a.ws + WS_SSP);
                {
                    pg8::Unit u0; u0.pm = 0; u0.pn = 0; so.next(0, u0);
                    LAS float* rsl = (LAS float*)(lds + pg8::STAGE_BYTES);
                    const int t_ = opaque_tid();
                    if (t_ < 256) rsl[t_] = row_rstd(e.ssp, u0.pm * 256 + t_);
                    e.rs_lds = rsl; e.pm0 = u0.pm;
                    __syncthreads();
                }
#if !(SKIPM & 2)
                pg8::gemm_phase(lds, g, so, e);
#endif
                const int nfull = (S / 256) * (NPROJ / 256);
                const int rem = nfull % G;
                const int wave = opaque_tid() >> 6;
#if !(SKIPM & 4)
                if (rem == 0 || G - rem < 64) dt_gemm(a, layer, vb, G, lds);
                else if (vb >= rem) dt_gemm(a, layer, vb - rem, G - rem, lds);
#endif
                if (layer + 1 < NL && !dummy) {
                    const int lane = opaque_tid() & 63;
                    LAS float* scr = (LAS float*)(lds + wave * 16896);
                    if (rem == 0 || G - rem < 64) { for (int it = CV_PER_L - CV_SLOT + vb * 8 + wave; it < CV_PER_L; it += G * 8) convert_item(a, layer + 1, it, scr, lane); }
                    else if (vb >= rem) { for (int it = CV_PER_L - CV_SLOT + (vb - rem) * 8 + wave; it < CV_PER_L; it += (G - rem) * 8) convert_item(a, layer + 1, it, scr, lane); }
                }
            } else if (sub == 1) {
#if !(SKIPM & 8)
                if (!(DUPM & 24) || !dummy || (DUPM & 8))
                for (int u = bx; u < 512; u += G) ssd_states_unit(a, layer, u >> 2, u & 3, lds);
#endif
            } else if (sub == 2) {
#if !(SKIPM & 32)
                phase_scan(a, a.ws + (dummy ? WS_END : WS_STATES));
#endif
            } else if (sub == 3) {
#if !(SKIPM & 64)
                for (int u = bx; u < 512; u += G) ssd_out_unit(a, layer, u >> 2, u & 3, lds);
#endif
                for (int u = bx; u < 16 * (S / ATT_Q); u += G) attn_unit(a, u & 15, u >> 4, lds);
            } else {
                pg8::Gemm g; g.A = (const bf16_t*)(a.ws + WS_MIX); g.Bt = (const bf16_t*)(a.ws + WS_WOUT) + (size_t)layer * DM * DMIX; g.M = S; g.N = DM; g.K = DMIX;
                pg8::StaticOrder so; so.init(S, DM, G, vb);
                pg8::EpiOutProj e; e.xb = (bf16_t*)(a.ws + WS_XB); e.ssp = (float*)(a.ws + WS_SSP);
#if !(SKIPM & 128)
                pg8::gemm_phase(lds, g, so, e);
#endif
            }
        }
        if (dummy) rep = 1; else { rep = 0; ++ph; }
        if (ph < a.ph_hi) {
            if (ph == 1 && !dummy) {
                cg::this_grid().sync();
                if (threadIdx.x == 0) (void)xb_add(&bar.bar[XB_XCNT(bar.x)], 1u);
            } else xcd_barrier(bar);
        }
    }
#if (DUPM & 256)
    for (int i = 0; i < 20; ++i) cg::this_grid().sync();
#endif
}

extern "C" void kernel_launch(void* const* d_in, const int* in_sizes, int n_in, void* d_out, int out_size, void* d_ws, size_t ws_size, hipStream_t stream) {
    static int grid = 0;
    if (grid == 0) {
        if (n_in != 11 || out_size != S * DM || ws_size < WS_END) { fprintf(stderr, "kernel_launch: unexpected shapes (n_in %d out %d ws %zu need %zu)\n", n_in, out_size, ws_size, (size_t)WS_END); grid = -1; return; }
        int dev = 0, cus = 0, per_cu = 0;
        hipGetDevice(&dev);
        hipDeviceGetAttribute(&cus, hipDeviceAttributeMultiprocessorCount, dev);
        if (hipFuncSetAttribute((const void*)hybrid_fwd, hipFuncAttributeMaxDynamicSharedMemorySize, LDS_BYTES) != hipSuccess) { fprintf(stderr, "kernel_launch: hipFuncSetAttribute failed\n"); grid = -1; return; }
        hipOccupancyMaxActiveBlocksPerMultiprocessor(&per_cu, (const void*)hybrid_fwd, 512, LDS_BYTES);
        (void)hipGetLastError();
        if (per_cu < 1) { fprintf(stderr, "kernel_launch: occupancy query says %d blocks per CU\n", per_cu); per_cu = 1; }
        grid = cus;
        if (grid != 256) fprintf(stderr, "kernel_launch: %d CUs; this build assumes 256\n", grid);
    }
    if (grid < 0) return;
    Args a{};
    a.x = (const float*)d_in[0]; a.norm_w = (const float*)d_in[1]; a.w_in = (const float*)d_in[2]; a.conv_w = (const float*)d_in[3]; a.conv_b = (const float*)d_in[4];
    a.dt_bias = (const float*)d_in[5]; a.a_log = (const float*)d_in[6]; a.d_skip = (const float*)d_in[7]; a.ssd_norm_w = (const float*)d_in[8];
    a.w_out = (const float*)d_in[9]; a.final_norm_w = (const float*)d_in[10];
    a.out = (float*)d_out; a.ws = (unsigned char*)d_ws;
#if ONE_LAUNCH
    a.ph_lo = 0; a.ph_hi = NPHASE;
    void* args[] = {&a};
    hipError_t e = hipLaunchCooperativeKernel((const void*)hybrid_fwd, dim3(grid), dim3(512), args, LDS_BYTES, stream);
    if (e != hipSuccess) fprintf(stderr, "cooperative launch failed: %s (grid %d)\n", hipGetErrorString(e), grid);
#else
    for (int ph = 0; ph < NPHASE; ++ph) {
        a.ph_lo = ph; a.ph_hi = ph + 1;
        hipLaunchKernelGGL(hybrid_fwd, dim3(grid), dim3(512), LDS_BYTES, stream, a);
    }
#endif
}
```
